# Optimizing an MI355X kernel written in HIP

```python
import math
import jax, jax.numpy as jnp
from jax import lax
import numpy as np

D_MODEL = 2048
BATCH = 4
SEQ = 4096
DEPTH = 1

CHUNK = 128
A_WIDTH = D_MODEL
A_GROUPS = 8
A_GROUP_DIM = A_WIDTH // A_GROUPS
R_HEADS = 8
R_QK_DIM = D_MODEL // (2 * R_HEADS)
R_V_DIM = D_MODEL // R_HEADS
R_QK_WIDTH = R_HEADS * R_QK_DIM
R_V_WIDTH = R_HEADS * R_V_DIM
ROPE_BASE = 10000.0
LN_EPS = 1e-5
DEEPNORM_ALPHA = (2 * DEPTH) ** 0.25
DEEPNORM_BETA = (8 * DEPTH) ** -0.25

IN_WIDTHS = (A_WIDTH, A_WIDTH, A_WIDTH,
             R_QK_WIDTH, R_QK_WIDTH, R_V_WIDTH, R_V_WIDTH,
             D_MODEL, D_MODEL)
IN_WIDTH = sum(IN_WIDTHS)
IN_SPLITS = tuple(int(s) for s in np.cumsum(IN_WIDTHS)[:-1])

kernel_name = "hybrid_gmlp_retention_gated_deepnorm"


def standardize(x):
    xf = x.astype(jnp.float32)
    mu = jnp.mean(xf, axis=-1, keepdims=True)
    var = jnp.mean(jnp.square(xf - mu), axis=-1, keepdims=True)
    return ((xf - mu) * lax.rsqrt(var + LN_EPS)).astype(x.dtype)


def layer_norm(x, g, b):
    return standardize(x) * g + b


def rotary(x, positions):
    d = x.shape[-1]
    freqs = ROPE_BASE ** (-jnp.arange(0, d, 2, dtype=jnp.float32) / d)
    ang = positions.astype(jnp.float32)[:, None] * freqs[None, :]
    cos = jnp.cos(ang).astype(x.dtype)[None, :, None, :]
    sin = jnp.sin(ang).astype(x.dtype)[None, :, None, :]
    x1, x2 = x[..., : d // 2], x[..., d // 2:]
    return jnp.concatenate([x1 * cos - x2 * sin, x1 * sin + x2 * cos], axis=-1)


def spatial_gating(u, v, ln_g, ln_b, w_s, b_s):
    bsz, s, _ = v.shape
    n = s // CHUNK
    v = layer_norm(v, ln_g, ln_b).reshape(bsz, n, CHUNK, A_GROUPS, A_GROUP_DIM)
    causal = jnp.tril(jnp.ones((CHUNK, CHUNK), dtype=w_s.dtype))
    ws = w_s * causal[None]
    sv = jnp.einsum('gts,bnsgc->bntgc', ws, v) + b_s.T[None, None, :, :, None]
    return u * sv.reshape(bsz, s, A_WIDTH)


def retention(q, k, v):
    bsz, s, h, dk = q.shape
    dv = v.shape[-1]
    n = s // CHUNK
    dt = q.dtype
    log_gamma = jnp.log1p(-jnp.exp2(-5.0 - jnp.arange(h, dtype=jnp.float32)))
    idx = jnp.arange(CHUNK, dtype=jnp.float32)
    q = q.reshape(bsz, n, CHUNK, h, dk)
    k = (k * (dk ** -0.5)).reshape(bsz, n, CHUNK, h, dk)
    v = v.reshape(bsz, n, CHUNK, h, dv)
    rel = idx[:, None] - idx[None, :]
    decay = jnp.where(rel[None] >= 0,
                      jnp.exp(log_gamma[:, None, None] * jnp.maximum(rel, 0.0)[None]), 0.0).astype(dt)
    scores = jnp.einsum('bnthd,bnshd->bnhts', q, k) * decay[None, None]
    inner = jnp.einsum('bnhts,bnshe->bnthe', scores, v)
    w_state = jnp.exp(log_gamma[None, :] * (CHUNK - 1 - idx)[:, None]).astype(dt)
    kv = jnp.einsum('bnshd,bnshe->bnhde', k * w_state[None, None, :, :, None], v)
    chunk_decay = jnp.exp(log_gamma * CHUNK).astype(kv.dtype)[None, :, None, None]

    def step(state, kv_i):
        return state * chunk_decay + kv_i, state

    init = jnp.zeros((bsz, h, dk, dv), dtype=kv.dtype)
    _, r_prev = lax.scan(step, init, jnp.moveaxis(kv, 1, 0))
    r_prev = jnp.moveaxis(r_prev, 0, 1)
    cross_decay = jnp.exp(log_gamma[None, :] * (idx + 1.0)[:, None]).astype(dt)
    cross = jnp.einsum('bnthd,bnhde->bnthe', q, r_prev) * cross_decay[None, None, :, :, None]
    out = standardize(inner + cross)
    return out.reshape(bsz, s, h * dv)


def setup_inputs(seed: int = 0) -> dict:
    key = jax.random.key(seed)
    ks = jax.random.split(key, 13)
    f32 = jnp.float32
    nrm = lambda k, shape: jax.random.normal(k, shape, dtype=f32)
    x = nrm(ks[0], (BATCH, SEQ, D_MODEL))
    w_in = nrm(ks[1], (DEPTH, D_MODEL, IN_WIDTH)) * D_MODEL ** -0.5
    b_gate = 0.01 * nrm(ks[2], (DEPTH, 2 * D_MODEL))
    ln_v_g = 1.0 + 0.02 * nrm(ks[3], (DEPTH, A_WIDTH))
    ln_v_b = 0.02 * nrm(ks[4], (DEPTH, A_WIDTH))
    w_s = nrm(ks[5], (DEPTH, A_GROUPS, CHUNK, CHUNK)) * CHUNK ** -0.5
    b_s = 1.0 + 0.02 * nrm(ks[6], (DEPTH, A_GROUPS, CHUNK))
    w_oa = nrm(ks[7], (DEPTH, A_WIDTH, D_MODEL)) * (A_WIDTH ** -0.5) * DEEPNORM_BETA
    w_ob = nrm(ks[8], (DEPTH, R_V_WIDTH, D_MODEL)) * (R_V_WIDTH ** -0.5) * DEEPNORM_BETA
    w_out = nrm(ks[9], (DEPTH, D_MODEL, D_MODEL)) * (D_MODEL ** -0.5) * DEEPNORM_BETA
    ln_g = 1.0 + 0.02 * nrm(ks[10], (DEPTH, D_MODEL))
    ln_b = 0.02 * nrm(ks[11], (DEPTH, D_MODEL))
    return {"x": x, "w_in": w_in, "b_gate": b_gate, "ln_v_g": ln_v_g, "ln_v_b": ln_v_b,
            "w_s": w_s, "b_s": b_s, "w_oa": w_oa, "w_ob": w_ob, "w_out": w_out,
            "ln_g": ln_g, "ln_b": ln_b}


def reference(x, w_in, b_gate, ln_v_g, ln_v_b, w_s, b_s, w_oa, w_ob, w_out, ln_g, ln_b):
    bsz, s, _ = x.shape
    positions = jnp.arange(s, dtype=jnp.int32)
    for l in range(DEPTH):
        h = x @ w_in[l]
        a_u, a_v, a_z, r_q, r_k, r_v, r_z, g_a, g_b = jnp.split(h, IN_SPLITS, axis=-1)
        ya = spatial_gating(jax.nn.gelu(a_u), jax.nn.gelu(a_v), ln_v_g[l], ln_v_b[l], w_s[l], b_s[l])
        ya = (ya * jax.nn.silu(a_z)) @ w_oa[l]
        q = rotary(r_q.reshape(bsz, s, R_HEADS, R_QK_DIM), positions)
        k = rotary(r_k.reshape(bsz, s, R_HEADS, R_QK_DIM), positions)
        ret = retention(q, k, r_v.reshape(bsz, s, R_HEADS, R_V_DIM))
        yb = (ret * jax.nn.silu(r_z)) @ w_ob[l]
        ga = jax.nn.sigmoid(g_a + b_gate[l, :D_MODEL])
        gb = jax.nn.sigmoid(g_b + b_gate[l, D_MODEL:])
        out = (ga * ya + gb * yb) @ w_out[l]
        x = layer_norm(DEEPNORM_ALPHA * x + out, ln_g[l], ln_b[l])
    return x
```

```cpp
#include <hip/hip_runtime.h>
#include <hip/hip_cooperative_groups.h>
#include <cstdio>
#include <cstdint>
#include <cmath>
namespace cg = cooperative_groups;

#ifndef MK_N_LAUNCHES
#define MK_N_LAUNCHES 1
#endif

#ifndef MIX_GATE
#define MIX_GATE 1
#endif
#ifndef MIX_KV
#define MIX_KV 1
#endif
#ifndef MIX_RET
#define MIX_RET 1
#endif
#define LAS __attribute__((address_space(3)))
#define GAS __attribute__((address_space(1)))
typedef unsigned short bf16_t;
typedef short bf16x8 __attribute__((ext_vector_type(8)));
typedef float f32x4 __attribute__((ext_vector_type(4)));
typedef float f32x2 __attribute__((ext_vector_type(2)));
typedef unsigned u32x4 __attribute__((ext_vector_type(4)));
typedef unsigned u32x2 __attribute__((ext_vector_type(2)));

constexpr int M = 16384, D = 2048, NIN = 16384, SEQ = 4096, NCH = 32  , CH = 128;
constexpr int NHEAD = 8, DK = 128, DV = 256;
constexpr float LN_EPS = 1e-5f;
constexpr float DN_ALPHA = 1.189207115002721f;
constexpr float K_SCALE = 0.08838834764831845f;

constexpr size_t MiB = 1u << 20;
constexpr size_t WS_CTL = 0;
constexpr size_t WS_WOA = 1 * MiB, WS_WOB = 9 * MiB, WS_WOUT = 17 * MiB;
constexpr size_t WS_CS = 25 * MiB;
constexpr size_t WS_WSM = 27 * MiB;
constexpr size_t WS_C2 = 27 * MiB + 512 * 1024;
constexpr size_t WS_VSTAT = 28 * MiB;
constexpr size_t WS_XB = 32 * MiB, WS_WIN = 96 * MiB;
constexpr size_t WS_UZ = 160 * MiB, WS_VT = 224 * MiB, WS_Q = 288 * MiB, WS_K = 320 * MiB, WS_RVT = 352 * MiB, WS_RZ = 416 * MiB;
constexpr size_t WS_KVT = 32 * MiB, WS_RT = 96 * MiB;
constexpr size_t WS_MB = 224 * MiB;
constexpr size_t WS_SCR = 480 * MiB;
constexpr size_t WS_KT = 480 * MiB;
constexpr size_t WS_END = 512 * MiB;

constexpr int LDS_BYTES = 147456;

__device__ __forceinline__ unsigned f2bf(float f) { unsigned u = __builtin_bit_cast(unsigned, f); return (u + 0x7fffu + ((u >> 16) & 1u)) >> 16; }
__device__ __forceinline__ unsigned pk2(float lo, float hi) { return f2bf(lo) | (f2bf(hi) << 16); }
__device__ __forceinline__ float bf2f(unsigned short b) { return __builtin_bit_cast(float, ((unsigned)b) << 16); }
__device__ __forceinline__ float bflo(unsigned w) { return __builtin_bit_cast(float, w << 16); }
__device__ __forceinline__ float bfhi(unsigned w) { return __builtin_bit_cast(float, w & 0xffff0000u); }
__device__ __forceinline__ float fast_sigmoid(float x) { return __builtin_amdgcn_rcpf(1.0f + __builtin_amdgcn_exp2f(-1.4426950408889634f * x)); }
__device__ __forceinline__ float silu_f(float x) { return x * fast_sigmoid(x); }
__device__ __forceinline__ float gelu_tanh_f(float x) {
    const float t = x * (1.0f + 0.044715f * x * x);
    return x * __builtin_amdgcn_rcpf(1.0f + __builtin_amdgcn_exp2f(-2.302208198f * t));
}
__device__ __forceinline__ float wave_sum(float v) {
#pragma unroll
    for (int o = 1; o < 64; o <<= 1) v += __shfl_xor(v, o);
    return v;
}
#define LDS_WAIT() asm volatile("s_waitcnt lgkmcnt(0)" ::: "memory")
#define VM_WAIT() asm volatile("s_waitcnt vmcnt(0)" ::: "memory")

namespace pg8 {
constexpr int BM = 256, BK = 64, HALF = 128, HTB = HALF * BK * 2  , STAGE_BYTES = 8 * HTB, NXCD = 8, WGM = 8;
constexpr int KDIM = 2048;

__host__ __device__ __forceinline__ int lds_byte(int r, int c) { const int st = (r >> 4) * 2 + (c >> 5), rr = r & 15, cc = c & 31, ob = rr * 64 + cc * 2; return st * 1024 + (ob ^ (((ob >> 9) & 1) << 5)); }
__host__ __device__ __forceinline__ void stage_rc(int b, int& R, int& C) { const int st = b / 1024, sb = b % 1024, swz = sb ^ (((sb >> 9) & 1) << 5); R = (st >> 1) * 16 + swz / 64; C = (st & 1) * 32 + (swz % 64) / 2; }
__host__ __device__ __forceinline__ int perm32(int rho) { const int n = rho >> 4, i = rho & 15; return 8 * (i >> 2) + 4 * n + (i & 3); }

struct Unit { int pm, pn, kind; const char* a; const char* b; };

__device__ __forceinline__ void tile_of(int L, int nM, int nN, int& pm, int& pn) {
    const int nwg = nM * nN; int wgid = L;
    { const int q = nwg / NXCD, r = nwg % NXCD, xcd = wgid % NXCD, off = wgid / NXCD; wgid = (xcd < r ? xcd * (q + 1) : r * (q + 1) + (xcd - r) * q) + off; }
    const int nig = WGM * nN, gid = wgid / nig, fm = gid * WGM, gsz = (nM - fm) < WGM ? (nM - fm) : WGM;
    pm = fm + ((wgid % nig) % gsz); pn = (wgid % nig) / gsz;
}

template <class Epi, class Sched>
__device__ __forceinline__ void gemm_phase(LAS unsigned char* lds, const Sched& S, const Epi& E) {
    const int tid = threadIdx.x, wid = __builtin_amdgcn_readfirstlane(tid >> 6), lane = tid & 63, wr = wid >> 2, wc = wid & 3, fr = lane & 15, fq = lane >> 4;
    constexpr int K = KDIM, nt = K / BK;
    unsigned voffA[2], voffB[2];
#pragma unroll
    for (int i = 0; i < 2; ++i) { int R, C; stage_rc(tid * 16 + i * 8192, R, C); const int Rb = Epi::PERM ? ((R & ~31) + perm32(R & 31)) : R;
        voffA[i] = (unsigned)(R * K + C) * 2u; voffB[i] = (unsigned)(Rb * K + C) * 2u; }
    constexpr size_t kstep = (size_t)(BK * 2);
    constexpr size_t hstep = (size_t)HALF * K * 2;
    const unsigned ldsw = (unsigned)wid * 1024u;
    const int aoff = lds_byte(wr * 64 + fr, fq * 8), boff = lds_byte(wc * 32 + fr, fq * 8);
#define PG8_SA(b, h) (((b) * 2 + (h)) * HTB)
#define PG8_SB(b, h) ((4 + (b) * 2 + (h)) * HTB)
#define PG8_STAGE(bufoff, gbase, voff) do { _Pragma("unroll") for (int _i = 0; _i < 2; ++_i) \
        __builtin_amdgcn_global_load_lds((const unsigned*)((const char*)(gbase) + (voff)[_i]), (LAS unsigned*)(lds + (bufoff) + ldsw + _i * 8192), 16, 0, 0); } while (0)
#define PG8_LDA(dst, b, h) do { _Pragma("unroll") for (int m = 0; m < 4; ++m) _Pragma("unroll") for (int k = 0; k < 2; ++k) dst[m][k] = *(const LAS bf16x8*)(lds + PG8_SA(b, h) + aoff + m * 2048 + k * 1024); } while (0)
#define PG8_LDB(dst, b, h) do { _Pragma("unroll") for (int n = 0; n < 2; ++n) _Pragma("unroll") for (int k = 0; k < 2; ++k) dst[n][k] = *(const LAS bf16x8*)(lds + PG8_SB(b, h) + boff + n * 2048 + k * 1024); } while (0)
#define PG8_MMA(ai, bj, At, Bt) do { __builtin_amdgcn_s_setprio(1); _Pragma("unroll") for (int m = 0; m < 4; ++m) _Pragma("unroll") for (int n = 0; n < 2; ++n) _Pragma("unroll") for (int k = 0; k < 2; ++k) \
        acc[ai][bj][m][n] = __builtin_amdgcn_mfma_f32_16x16x32_bf16(Bt[n][k], At[m][k], acc[ai][bj][m][n], 0, 0, 0); __builtin_amdgcn_s_setprio(0); } while (0)
#define PG8_WAIT_V(n) asm volatile("s_waitcnt vmcnt(" #n ")" ::: "memory")
#define PG8_WAIT_L(n) asm volatile("s_waitcnt lgkmcnt(" #n ")" ::: "memory")
#define PG8_BAR __builtin_amdgcn_s_barrier()
#define PG8_SCHED __builtin_amdgcn_sched_barrier(0)
    Unit cur, nxt; int ui = 0;
    if (!S.next(0, cur)) return;
    f32x4 acc[2][2][4][2];
#pragma unroll
    for (int a = 0; a < 2; ++a)
#pragma unroll
        for (int b = 0; b < 2; ++b)
#pragma unroll
            for (int m = 0; m < 4; ++m)
#pragma unroll
                for (int n = 0; n < 2; ++n) acc[a][b][m][n] = (f32x4){0.f, 0.f, 0.f, 0.f};
    bf16x8 At[4][2], B0[2][2], B1[2][2];
    const char* cA = cur.a; const char* cB = cur.b;
    PG8_STAGE(PG8_SB(0, 0), cB, voffB); PG8_STAGE(PG8_SA(0, 0), cA, voffA); PG8_STAGE(PG8_SB(0, 1), cB + hstep, voffB); PG8_STAGE(PG8_SA(0, 1), cA + hstep, voffA);
    if (wr == 1) PG8_BAR;
    PG8_WAIT_V(4); PG8_BAR;
    PG8_STAGE(PG8_SB(1, 0), cB + kstep, voffB); PG8_STAGE(PG8_SA(1, 0), cA + kstep, voffA); PG8_STAGE(PG8_SB(1, 1), cB + hstep + kstep, voffB);
    PG8_WAIT_V(6); PG8_BAR;
    for (;;) {
        const bool has_next = S.next(ui + 1, nxt);
        const char* nA = has_next ? nxt.a : cA; const char* nB = has_next ? nxt.b : cB;
        for (int t = 0; t < nt; t += 2) {
            const bool last = (t == nt - 2);
            const char* a1 = cA + (size_t)(t + 1) * kstep;
            const char* a2 = last ? nA : cA + (size_t)(t + 2) * kstep; const char* b2 = last ? nB : cB + (size_t)(t + 2) * kstep;
            const char* a3 = a2 + kstep; const char* b3 = b2 + kstep;
            PG8_LDB(B0, 0, 0); PG8_SCHED; PG8_LDA(At, 0, 0); PG8_STAGE(PG8_SA(1, 1), a1 + hstep, voffA);
            PG8_WAIT_L(8); PG8_BAR; PG8_WAIT_L(0); PG8_MMA(0, 0, At, B0); PG8_BAR; PG8_SCHED;
            PG8_LDB(B1, 0, 1); PG8_STAGE(PG8_SB(0, 0), b2, voffB);
            PG8_BAR; PG8_WAIT_L(0); PG8_MMA(0, 1, At, B1); PG8_BAR;
            PG8_LDA(At, 0, 1); PG8_STAGE(PG8_SA(0, 0), a2, voffA);
            PG8_BAR; PG8_WAIT_L(0); PG8_MMA(1, 0, At, B0); PG8_BAR; PG8_SCHED;
            PG8_STAGE(PG8_SB(0, 1), b2 + hstep, voffB);
            PG8_WAIT_V(6); PG8_BAR; PG8_MMA(1, 1, At, B1); PG8_BAR;
            PG8_LDB(B0, 1, 0); PG8_SCHED; PG8_LDA(At, 1, 0); PG8_STAGE(PG8_SA(0, 1), a2 + hstep, voffA);
            PG8_WAIT_L(8); PG8_BAR; PG8_WAIT_L(0); PG8_MMA(0, 0, At, B0); PG8_BAR; PG8_SCHED;
            PG8_LDB(B1, 1, 1); PG8_STAGE(PG8_SB(1, 0), b3, voffB);
            PG8_BAR; PG8_WAIT_L(0); PG8_MMA(0, 1, At, B1); PG8_BAR;
            PG8_LDA(At, 1, 1); PG8_STAGE(PG8_SA(1, 0), a3, voffA);
            PG8_BAR; PG8_WAIT_L(0); PG8_MMA(1, 0, At, B0); PG8_BAR; PG8_SCHED;
            PG8_STAGE(PG8_SB(1, 1), b3 + hstep, voffB);
            PG8_WAIT_V(6); PG8_BAR; PG8_MMA(1, 1, At, B1); PG8_BAR;
        }
        E(acc, cur, wr, wc, fr, fq);
        if (!has_next) break;
#pragma unroll
        for (int a = 0; a < 2; ++a)
#pragma unroll
            for (int b = 0; b < 2; ++b)
#pragma unroll
                for (int m = 0; m < 4; ++m)
#pragma unroll
                    for (int n = 0; n < 2; ++n) acc[a][b][m][n] = (f32x4){0.f, 0.f, 0.f, 0.f};
        cur = nxt; cA = nA; cB = nB; ++ui;
    }
    PG8_WAIT_V(0);
    if (wr == 0) PG8_BAR;
    PG8_BAR;
#undef PG8_SA
#undef PG8_SB
#undef PG8_STAGE
#undef PG8_LDA
#undef PG8_LDB
#undef PG8_MMA
#undef PG8_WAIT_V
#undef PG8_WAIT_L
#undef PG8_BAR
#undef PG8_SCHED
}
}

struct Args {
    const float* in[12];
    float* out; unsigned char* ws;
    float freq[64];
    float lg2[8];
    int ph_lo, ph_hi;
};

enum { KIND_UZ = 0, KIND_V = 1, KIND_Q = 2, KIND_K = 3, KIND_RV = 4, KIND_RZ = 5, KIND_GA = 6, KIND_GB = 7 };
__host__ __device__ __forceinline__ int p1_kind(int pn) { return pn < 16 ? KIND_UZ : pn < 24 ? KIND_V : pn < 28 ? KIND_Q : pn < 32 ? KIND_K : pn < 40 ? KIND_RV : pn < 48 ? KIND_RZ : pn < 56 ? KIND_GA : KIND_GB; }
__host__ __device__ __forceinline__ int p1_col(int rho) {
    const int tile = rho >> 8, w = rho & 255;
    if (tile < 16) return (w < 128) ? 128 * tile + w : 4096 + 128 * tile + (w - 128);
    if (tile < 24) return 2048 + 256 * (tile - 16) + w;
    if (tile < 32) { const int base = tile < 28 ? 6144 : 7168, hp = (tile - 24) & 3, hh = (w & 127) >> 6, d = (w & 63) + 64 * (w >> 7); return base + (2 * hp + hh) * 128 + d; }
    return 8192 + 256 * (tile - 32) + w;
}

struct OrderP1 {
    int G, c; const char* xb; const char* win;
    __device__ __forceinline__ bool next(int i, pg8::Unit& u) const {
        const int L = i * G + c; if (L >= 64 * 64) return false;
        pg8::tile_of(L, 64, 64, u.pm, u.pn); u.kind = p1_kind(u.pn);
        const char* xa = xb + (size_t)u.pm * (256 * 2048 * 2); const char* wb = win + (size_t)u.pn * (256 * 2048 * 2);
        const bool sw = (u.kind == KIND_V) || (u.kind == KIND_RV);
        u.a = sw ? wb : xa; u.b = sw ? xa : wb; return true;
    }
};

struct EpiP1 {
    static constexpr bool PERM = true;
    unsigned char* ws; bf16_t* gout; const float* bgate;
    __device__ __forceinline__ void operator()(const f32x4 (&acc)[2][2][4][2], const pg8::Unit& u, int wr, int wc, int fr, int fq) const {
        const int kind = u.kind;
        bf16_t* const uz = (bf16_t*)(ws + WS_UZ); float* const vstat = (float*)(ws + WS_VSTAT); const f32x2* const cs = (const f32x2*)(ws + WS_CS);
        if (kind == KIND_UZ) {
            const int row0 = u.pm * 256 + wr * 64 + fr, col0 = u.pn * 128 + wc * 32 + 8 * fq;
#pragma unroll
            for (int ai = 0; ai < 2; ++ai)
#pragma unroll
                for (int m = 0; m < 4; ++m) {
                    const f32x4 u0 = acc[ai][0][m][0], u1 = acc[ai][0][m][1], z0 = acc[ai][1][m][0], z1 = acc[ai][1][m][1];
                    float r[8];
#pragma unroll
                    for (int j = 0; j < 4; ++j) { r[j] = gelu_tanh_f(u0[j]) * silu_f(z0[j]); r[4 + j] = gelu_tanh_f(u1[j]) * silu_f(z1[j]); }
                    u32x4 w; w.x = pk2(r[0], r[1]); w.y = pk2(r[2], r[3]); w.z = pk2(r[4], r[5]); w.w = pk2(r[6], r[7]);
                    *(u32x4*)(uz + (size_t)(row0 + ai * 128 + m * 16) * D + col0) = w;
                }
        } else if (kind == KIND_V || kind == KIND_RV) {
            const int chb = (kind == KIND_V ? (u.pn - 16) : (u.pn - 32)) * 256 + wr * 64 + fr;
            bf16_t* dst = (bf16_t*)(ws + (kind == KIND_V ? WS_VT : WS_RVT));
            const int b = u.pm >> 4, nc0 = (u.pm & 15) * 2, s0 = wc * 32 + 8 * fq;
            float ssum[2][8], ssq[2][8];
#pragma unroll
            for (int bj = 0; bj < 2; ++bj)
#pragma unroll
                for (int j = 0; j < 8; ++j) { ssum[bj][j] = 0.f; ssq[bj][j] = 0.f; }
#pragma unroll
            for (int ai = 0; ai < 2; ++ai)
#pragma unroll
                for (int m = 0; m < 4; ++m) {
                    const int ch = chb + ai * 128 + m * 16;
#pragma unroll
                    for (int bj = 0; bj < 2; ++bj) {
                        float r[8];
#pragma unroll
                        for (int j = 0; j < 4; ++j) { r[j] = acc[ai][bj][m][0][j]; r[4 + j] = acc[ai][bj][m][1][j]; }
                        if (kind == KIND_V) {
#pragma unroll
                            for (int j = 0; j < 8; ++j) { r[j] = gelu_tanh_f(r[j]); ssum[bj][j] += r[j]; ssq[bj][j] += r[j] * r[j]; }
                        }
                        u32x4 w; w.x = pk2(r[0], r[1]); w.y = pk2(r[2], r[3]); w.z = pk2(r[4], r[5]); w.w = pk2(r[6], r[7]);
                        *(u32x4*)(dst + ((size_t)((b * NCH + nc0 + bj) * 2048 + ch)) * CH + s0) = w;
                    }
                }
            if (kind == KIND_V) {
#pragma unroll
                for (int bj = 0; bj < 2; ++bj)
#pragma unroll
                    for (int j = 0; j < 8; ++j) {
                        float a = ssum[bj][j], q2 = ssq[bj][j];
                        a += __shfl_xor(a, 1); a += __shfl_xor(a, 2); a += __shfl_xor(a, 4); a += __shfl_xor(a, 8);
                        q2 += __shfl_xor(q2, 1); q2 += __shfl_xor(q2, 2); q2 += __shfl_xor(q2, 4); q2 += __shfl_xor(q2, 8);
                        if (fr == 0) { float* p = vstat + (size_t)(u.pm * 256 + bj * 128 + s0 + j) * 2; atomicAdd(p, a); atomicAdd(p + 1, q2); }
                    }
            }
        } else if (kind == KIND_Q || kind == KIND_K) {
            const int row0 = u.pm * 256 + wr * 64 + fr;
            const int hp = (u.pn - 24) & 3, head = 2 * hp + (wc >> 1), d0 = (wc & 1) * 32 + 8 * fq;
            bf16_t* dst = (bf16_t*)(ws + (kind == KIND_Q ? WS_Q : WS_K)); const float sc = (kind == KIND_Q) ? 1.0f : K_SCALE;
#pragma unroll
            for (int ai = 0; ai < 2; ++ai)
#pragma unroll
                for (int m = 0; m < 4; ++m) {
                    const int row = row0 + ai * 128 + m * 16, pos = row & (SEQ - 1);
                    const f32x4* cp = (const f32x4*)(cs + (size_t)pos * 64 + d0);
                    const f32x4 c01 = cp[0], c23 = cp[1], c45 = cp[2], c67 = cp[3];
                    const float cs8[8] = {c01[0], c01[2], c23[0], c23[2], c45[0], c45[2], c67[0], c67[2]};
                    const float sn8[8] = {c01[1], c01[3], c23[1], c23[3], c45[1], c45[3], c67[1], c67[3]};
                    float o1[8], o2[8];
#pragma unroll
                    for (int j = 0; j < 8; ++j) {
                        const float x1 = (j < 4) ? acc[ai][0][m][0][j & 3] : acc[ai][0][m][1][j & 3];
                        const float x2 = (j < 4) ? acc[ai][1][m][0][j & 3] : acc[ai][1][m][1][j & 3];
                        o1[j] = (x1 * cs8[j] - x2 * sn8[j]) * sc; o2[j] = (x1 * sn8[j] + x2 * cs8[j]) * sc;
                    }
                    u32x4 w1, w2; w1.x = pk2(o1[0], o1[1]); w1.y = pk2(o1[2], o1[3]); w1.z = pk2(o1[4], o1[5]); w1.w = pk2(o1[6], o1[7]);
                    w2.x = pk2(o2[0], o2[1]); w2.y = pk2(o2[2], o2[3]); w2.z = pk2(o2[4], o2[5]); w2.w = pk2(o2[6], o2[7]);
                    bf16_t* rp = dst + (size_t)row * 1024 + head * 128 + d0;
                    *(u32x4*)rp = w1; *(u32x4*)(rp + 64) = w2;
                    if (kind == KIND_K) {
                        bf16_t* tp = (bf16_t*)(ws + WS_KT) + ((size_t)(row >> 7) * 1024 + head * 128 + d0) * CH + (row & 127);
                        const unsigned a1[4] = {w1.x, w1.y, w1.z, w1.w}, a2[4] = {w2.x, w2.y, w2.z, w2.w};
#pragma unroll
                        for (int j = 0; j < 4; ++j) {
                            tp[(2 * j) * CH] = (bf16_t)(a1[j] & 0xffffu); tp[(2 * j + 1) * CH] = (bf16_t)(a1[j] >> 16);
                            tp[(64 + 2 * j) * CH] = (bf16_t)(a2[j] & 0xffffu); tp[(64 + 2 * j + 1) * CH] = (bf16_t)(a2[j] >> 16);
                        }
                    }
                }
        } else if (kind == KIND_RZ) {
            bf16_t* dst = (bf16_t*)(ws + WS_RZ);
            const int row0 = u.pm * 256 + wr * 64 + fr, col0 = (u.pn - 40) * 256 + wc * 32 + 8 * fq;
#pragma unroll
            for (int ai = 0; ai < 2; ++ai)
#pragma unroll
                for (int m = 0; m < 4; ++m) {
                    bf16_t* rowp = dst + (size_t)(row0 + ai * 128 + m * 16) * D + col0;
#pragma unroll
                    for (int bj = 0; bj < 2; ++bj) {
                        const f32x4 v0 = acc[ai][bj][m][0], v1 = acc[ai][bj][m][1];
                        float r[8];
#pragma unroll
                        for (int j = 0; j < 4; ++j) { r[j] = silu_f(v0[j]); r[4 + j] = silu_f(v1[j]); }
                        u32x4 w; w.x = pk2(r[0], r[1]); w.y = pk2(r[2], r[3]); w.z = pk2(r[4], r[5]); w.w = pk2(r[6], r[7]);
                        *(u32x4*)(rowp + bj * 128) = w;
                    }
                }
        } else {
            const int isb = (kind == KIND_GB) ? 1 : 0;
            bf16_t* dst = gout + (size_t)isb * ((size_t)M * D);
            const int row0 = u.pm * 256 + wr * 64 + fr, col0 = (u.pn - 48 - 8 * isb) * 256 + wc * 32 + 8 * fq;
            const float* bp = bgate + isb * 2048 + col0;
            f32x4 bv[2][2];
#pragma unroll
            for (int bj = 0; bj < 2; ++bj)
#pragma unroll
                for (int n = 0; n < 2; ++n) bv[bj][n] = *(const f32x4*)(bp + bj * 128 + 4 * n);
#pragma unroll
            for (int ai = 0; ai < 2; ++ai)
#pragma unroll
                for (int m = 0; m < 4; ++m) {
                    bf16_t* rowp = dst + (size_t)(row0 + ai * 128 + m * 16) * D + col0;
#pragma unroll
                    for (int bj = 0; bj < 2; ++bj) {
                        const f32x4 v0 = acc[ai][bj][m][0] + bv[bj][0], v1 = acc[ai][bj][m][1] + bv[bj][1];
                        float r[8];
#pragma unroll
                        for (int j = 0; j < 4; ++j) { r[j] = fast_sigmoid(v0[j]); r[4 + j] = fast_sigmoid(v1[j]); }
                        u32x4 w; w.x = pk2(r[0], r[1]); w.y = pk2(r[2], r[3]); w.z = pk2(r[4], r[5]); w.w = pk2(r[6], r[7]);
                        *(u32x4*)(rowp + bj * 128) = w;
                    }
                }
        }
    }
};

struct OrderP3 {
    int G, c; const char *apre, *bpre, *woa, *wob;
    __device__ __forceinline__ bool next(int i, pg8::Unit& u) const {
        const int L = (i >> 1) * G + c; if (L >= 64 * 8) return false;
        pg8::tile_of(L, 64, 8, u.pm, u.pn); u.kind = i & 1;
        u.a = (u.kind ? bpre : apre) + (size_t)u.pm * (256 * 2048 * 2); u.b = (u.kind ? wob : woa) + (size_t)u.pn * (256 * 2048 * 2); return true;
    }
};
struct EpiP3 {
    static constexpr bool PERM = true;
    const bf16_t *ga, *gb; bf16_t* mb;
    __device__ __forceinline__ void operator()(const f32x4 (&acc)[2][2][4][2], const pg8::Unit& u, int wr, int wc, int fr, int fq) const {
        const int row0 = u.pm * 256 + wr * 64 + fr, col0 = u.pn * 256 + wc * 32 + 8 * fq;
        const bf16_t* g = u.kind ? gb : ga;
#pragma unroll
        for (int ai = 0; ai < 2; ++ai)
#pragma unroll
            for (int m = 0; m < 4; ++m) {
                const size_t off = (size_t)(row0 + ai * 128 + m * 16) * D + col0;
#pragma unroll
                for (int bj = 0; bj < 2; ++bj) {
                    const u32x4 gw = *(const u32x4*)(g + off + bj * 128);
                    const f32x4 v0 = acc[ai][bj][m][0], v1 = acc[ai][bj][m][1];
                    float r[8] = {bflo(gw.x) * v0[0], bfhi(gw.x) * v0[1], bflo(gw.y) * v0[2], bfhi(gw.y) * v0[3],
                                  bflo(gw.z) * v1[0], bfhi(gw.z) * v1[1], bflo(gw.w) * v1[2], bfhi(gw.w) * v1[3]};
                    if (u.kind) {
                        const u32x4 pw = *(const u32x4*)(mb + off + bj * 128);
                        r[0] += bflo(pw.x); r[1] += bfhi(pw.x); r[2] += bflo(pw.y); r[3] += bfhi(pw.y);
                        r[4] += bflo(pw.z); r[5] += bfhi(pw.z); r[6] += bflo(pw.w); r[7] += bfhi(pw.w);
                    }
                    u32x4 w; w.x = pk2(r[0], r[1]); w.y = pk2(r[2], r[3]); w.z = pk2(r[4], r[5]); w.w = pk2(r[6], r[7]);
                    *(u32x4*)(mb + off + bj * 128) = w;
                }
            }
    }
};

struct OrderP4 {
    int G, c; const char *mb, *wout;
    __device__ __forceinline__ bool next(int i, pg8::Unit& u) const {
        const int L = i * G + c; if (L >= 64 * 8) return false;
        pg8::tile_of(L, 64, 8, u.pm, u.pn); u.kind = 0;
        u.a = mb + (size_t)u.pm * (256 * 2048 * 2); u.b = wout + (size_t)u.pn * (256 * 2048 * 2); return true;
    }
};
struct EpiP4 {
    static constexpr bool PERM = false;
    const float* x; float* out;
    __device__ __forceinline__ void operator()(const f32x4 (&acc)[2][2][4][2], const pg8::Unit& u, int wr, int wc, int fr, int fq) const {
        const int row0 = u.pm * 256 + wr * 64 + fr, col0 = u.pn * 256 + wc * 32 + 4 * fq;
#pragma unroll
        for (int ai = 0; ai < 2; ++ai)
#pragma unroll
            for (int m = 0; m < 4; ++m) {
                const size_t off = (size_t)(row0 + ai * 128 + m * 16) * D + col0;
#pragma unroll
                for (int bj = 0; bj < 2; ++bj)
#pragma unroll
                    for (int n = 0; n < 2; ++n) {
                        const f32x4 xv = *(const f32x4*)(x + off + bj * 128 + n * 16);
                        *(f32x4*)(out + off + bj * 128 + n * 16) = xv * DN_ALPHA + acc[ai][bj][m][n];
                    }
            }
    }
};


#ifndef MK_XCD_BARRIER
#define MK_XCD_BARRIER 1
#endif
constexpr int CW_BAR = 4096;
constexpr size_t CTL_ZERO_BYTES = 65536;
#define XB_TMO      128
#define XB_XCNT(j)  (256  + 64 * (j))
#define XB_XSUB(j)  (1280 + 64 * (j))
#define XB_XGEN(j)  (2304 + 64 * (j))
#define XB_TOP      3328
#define XB_TOPGEN   3392
#define XCD_BAR_WORDS 3456
#define XB_SPIN_CAP (1u << 18)
__device__ __forceinline__ unsigned xb_ld(unsigned* p)              { return __hip_atomic_load(p, __ATOMIC_RELAXED, __HIP_MEMORY_SCOPE_AGENT); }
__device__ __forceinline__ unsigned xb_add(unsigned* p, unsigned v) { return __hip_atomic_fetch_add(p, v, __ATOMIC_RELAXED, __HIP_MEMORY_SCOPE_AGENT); }
__device__ __forceinline__ unsigned xb_xcc_id() { return (unsigned)__builtin_amdgcn_s_getreg((3 << 11) | 20) & 0xFu; }
#define XB_SPIN(cond, bar) do { unsigned _sp = 0; while (cond) { __builtin_amdgcn_s_sleep(1); \
    if ((++_sp & 255u) == 0u) { if (xb_ld(&(bar)[XB_TMO])) break; if (_sp > XB_SPIN_CAP) { atomicAdd(&(bar)[XB_TMO], 1u); break; } } } } while (0)
struct XcdBarrier { unsigned* bar; unsigned x; volatile LAS unsigned* st; };
__device__ __forceinline__ XcdBarrier xcd_barrier_post(unsigned* bar, volatile LAS unsigned* st) {
    XcdBarrier b; b.bar = bar; b.x = xb_xcc_id(); b.st = st;
    if (threadIdx.x == 0) (void)xb_add(&bar[XB_XCNT(b.x)], 1u);
    return b;
}
__device__ __forceinline__ void xcd_barrier_complete(unsigned* bar, unsigned x, unsigned& nloc, unsigned& nx) {
    const unsigned G = gridDim.x * gridDim.y * gridDim.z;
    unsigned sum, cnt, mine, sp = 0u;
    for (;;) {
        sum = 0u; cnt = 0u; mine = 0u;
#pragma unroll
        for (unsigned j = 0; j < 16; ++j) { const unsigned c = xb_ld(&bar[XB_XCNT(j)]); sum += c; cnt += (c > 0u) ? 1u : 0u; mine = (j == x) ? c : mine; }
        if (sum == G) break;
        __builtin_amdgcn_s_sleep(1);
        if ((++sp & 255u) == 0u) { if (xb_ld(&bar[XB_TMO])) break; if (sp > XB_SPIN_CAP) { atomicAdd(&bar[XB_TMO], 1u); break; } }
    }
    nloc = mine > 0u ? mine : 1u; nx = cnt > 0u ? cnt : 1u;
}
__device__ __forceinline__ void xcd_barrier(const XcdBarrier& b) {
    asm volatile("s_waitcnt vmcnt(0)" ::: "memory");
    __syncthreads();
    if (threadIdx.x == 0) {
        unsigned* bar = b.bar;
        __builtin_amdgcn_s_waitcnt(0);
        unsigned nloc = b.st[0], nx = b.st[1];
        if (nloc == 0u) { xcd_barrier_complete(bar, b.x, nloc, nx); b.st[0] = nloc; b.st[1] = nx; }
        const unsigned old = xb_add(&bar[XB_XSUB(b.x)], 1u);
        const unsigned gen = old / nloc;
        if (old + 1u == (gen + 1u) * nloc) {
            __builtin_amdgcn_fence(__ATOMIC_RELEASE, "agent");
            asm volatile("s_waitcnt vmcnt(0)" ::: "memory");
            const unsigned og = xb_add(&bar[XB_TOP], 1u);
            const unsigned tg = og / nx;
            if (og + 1u == (tg + 1u) * nx) xb_add(&bar[XB_TOPGEN], 1u);
            else XB_SPIN(xb_ld(&bar[XB_TOPGEN]) == tg, bar);
            __builtin_amdgcn_fence(__ATOMIC_ACQUIRE, "agent");
            xb_add(&bar[XB_XGEN(b.x)], 1u);
            asm volatile("s_waitcnt vmcnt(0)" ::: "memory");
        } else {
            XB_SPIN(xb_ld(&bar[XB_XGEN(b.x)]) == gen, bar);
            __builtin_amdgcn_fence(__ATOMIC_ACQUIRE, "agent");
            asm volatile("s_waitcnt vmcnt(0)" ::: "memory");
        }
    }
    __syncthreads();
}

struct Frame {
    LAS unsigned char* lds;
    int tid, lane, wave, vcu, G;
};

__device__ __forceinline__ void p0_transpose_item(const float* W, int N, bf16_t* WT, int row_dst0, int n_src0, int k0, LAS float* scr, int lane) {
    float tv[32];
#pragma unroll
    for (int i = 0; i < 32; ++i) tv[i] = W[(size_t)(k0 + 2 * i + (lane >> 5)) * N + n_src0 + (lane & 31)];
#pragma unroll
    for (int i = 0; i < 32; ++i) scr[(2 * i + (lane >> 5)) * 33 + (lane & 31)] = tv[i];
    LDS_WAIT(); asm volatile("" ::: "memory");
    const int c = lane & 7;
#pragma unroll
    for (int j = 0; j < 4; ++j) { const int n = (lane >> 3) + 8 * j; const LAS float* s = scr + (8 * c) * 33 + n;
        u32x4 o; o.x = pk2(s[0 * 33], s[1 * 33]); o.y = pk2(s[2 * 33], s[3 * 33]); o.z = pk2(s[4 * 33], s[5 * 33]); o.w = pk2(s[6 * 33], s[7 * 33]);
        *(u32x4*)(WT + (size_t)(row_dst0 + n) * 2048 + k0 + 8 * c) = o; }
    LDS_WAIT(); asm volatile("" ::: "memory");
}
__device__ __forceinline__ void sincos_d(float a, float& c, float& s) {
    const double x = (double)a;
    const double kq = __builtin_rint(x * 0.63661977236758134308);
    double y = __builtin_fma(-kq, 1.57079632679489655800e+00, x);
    y = __builtin_fma(-kq, 6.12323399573676603587e-17, y);
    const double y2 = y * y;
    double sp = -7.6471637318198164759e-13;
    sp = sp * y2 + 1.6059043836821614599e-10; sp = sp * y2 - 2.5052108385441718775e-08; sp = sp * y2 + 2.7557319223985890653e-06;
    sp = sp * y2 - 1.9841269841269841270e-04; sp = sp * y2 + 8.3333333333333333333e-03; sp = sp * y2 - 1.6666666666666666667e-01;
    const double sy = y + y * y2 * sp;
    double cp = 4.7794773323873852974e-14;
    cp = cp * y2 - 1.1470745597729724714e-11; cp = cp * y2 + 2.0876756987868098979e-09; cp = cp * y2 - 2.7557319223985890653e-07;
    cp = cp * y2 + 2.4801587301587301587e-05; cp = cp * y2 - 1.3888888888888888889e-03; cp = cp * y2 + 4.1666666666666666667e-02; cp = cp * y2 - 0.5;
    const double cy = 1.0 + y2 * cp;
    const int qd = ((int)kq) & 3;
    const double cc = (qd == 0) ? cy : (qd == 1) ? -sy : (qd == 2) ? -cy : sy;
    const double ss = (qd == 0) ? sy : (qd == 1) ? cy : (qd == 2) ? -sy : -cy;
    c = (float)cc; s = (float)ss;
}

__device__ __forceinline__ void p0_prologue(const Frame& F, const Args& a) {
    unsigned char* ws = a.ws;
    const int gt = F.vcu * 512 + F.tid, NT = F.G * 512;
    const int gw = F.vcu * 8 + F.wave, NGW = F.G * 8;
    { f32x4* p = (f32x4*)(ws + WS_VSTAT); for (int i = gt; i < M * 2 / 4; i += NT) p[i] = (f32x4){0.f, 0.f, 0.f, 0.f}; }
    { f32x2* cs = (f32x2*)(ws + WS_CS);
      for (int i = gt; i < SEQ * 64; i += NT) { const int pos = i >> 6, j = i & 63; const float ang = (float)pos * a.freq[j]; float c, s; sincos_d(ang, c, s); cs[i] = (f32x2){c, s}; } }
    { const float* w_s = a.in[5]; bf16_t* wsm = (bf16_t*)(ws + WS_WSM); float* c2 = (float*)(ws + WS_C2);
      for (int r = gt; r < 8 * 128; r += NT) { const int t = r & 127; float sum = 0.f;
          for (int s = 0; s < 128; ++s) { const float v = (s <= t) ? w_s[(size_t)r * 128 + s] : 0.f; const unsigned b = f2bf(v); wsm[(size_t)r * 128 + s] = (bf16_t)b; sum += bf2f((bf16_t)b); }
          c2[r] = sum; } }
    { const f32x4* x4 = (const f32x4*)a.in[0]; u32x4* xb = (u32x4*)(ws + WS_XB);
      for (int i = gt; i < M * D / 8; i += 4 * NT) { f32x4 v0[4], v1[4];
#pragma unroll
          for (int j = 0; j < 4; ++j) { v0[j] = x4[2 * (i + j * NT)]; v1[j] = x4[2 * (i + j * NT) + 1]; }
#pragma unroll
          for (int j = 0; j < 4; ++j) { u32x4 o; o.x = pk2(v0[j][0], v0[j][1]); o.y = pk2(v0[j][2], v0[j][3]); o.z = pk2(v1[j][0], v1[j][1]); o.w = pk2(v1[j][2], v1[j][3]); xb[i + j * NT] = o; } } }
    { LAS float* scr = (LAS float*)(F.lds + F.wave * 16384);
      constexpr int I_IN = (2048 / 64) * (NIN / 32), I_S = (2048 / 64) * (2048 / 32);
      for (int it = gw; it < I_IN + 3 * I_S; it += NGW) {
          if (it < I_IN) { const int kb = it & 31, rb = it >> 5; p0_transpose_item(a.in[1], NIN, (bf16_t*)(ws + WS_WIN), rb * 32, p1_col(rb * 32), kb * 64, scr, F.lane); }
          else { const int r = it - I_IN, w = r / I_S, q = r % I_S, kb = q & 31, rb = q >> 5;
              const float* W = (w == 0) ? a.in[7] : (w == 1) ? a.in[8] : a.in[9]; bf16_t* WT = (bf16_t*)(ws + (w == 0 ? WS_WOA : w == 1 ? WS_WOB : WS_WOUT));
              p0_transpose_item(W, 2048, WT, rb * 32, rb * 32, kb * 64, scr, F.lane); }
      } }
}

__device__ __forceinline__ void naive_gate_unit(const Frame& F, const Args& a, int unit) {
    unsigned char* ws = a.ws;
    const int g = unit & 7, n = (unit >> 3) & 31, b = unit >> 8;
    const int t0 = b * SEQ + n * CH, c0 = g * 256;
    LAS float* vn = (LAS float*)F.lds;
    LAS float* mu = (LAS float*)(F.lds + 131072);
    LAS float* rs = mu + 128;
    const float* vstat = (const float*)(ws + WS_VSTAT);
    const bf16_t* vT = (const bf16_t*)(ws + WS_VT) + (size_t)((b * NCH + n) * 2048 + c0) * CH;
    const float* lng = a.in[3]; const float* lnb = a.in[4]; const float* w_s = a.in[5]; const float* b_s = a.in[6];
    bf16_t* uz = (bf16_t*)(ws + WS_UZ);
    __syncthreads();
    if (F.tid < 128) { const float s1 = vstat[(size_t)(t0 + F.tid) * 2], s2 = vstat[(size_t)(t0 + F.tid) * 2 + 1]; const float m = s1 * (1.0f / 2048.0f); float var = s2 * (1.0f / 2048.0f) - m * m; var = var > 0.f ? var : 0.f;
        mu[F.tid] = m; rs[F.tid] = 1.0f / sqrtf(var + LN_EPS); }
    __syncthreads();
    for (int i = F.tid; i < 256 * 128; i += 512) { const int c = i >> 7, s = i & 127; const float v = bf2f(vT[i]);
        vn[s * 256 + c] = (v - mu[s]) * rs[s] * lng[c0 + c] + lnb[c0 + c]; }
    __syncthreads();
    const int c = F.tid & 255, th = F.tid >> 8;
    for (int t = th; t < 128; t += 2) {
        const float* wrow = w_s + ((size_t)g * 128 + t) * 128;
        float acc = 0.f;
        for (int s = 0; s <= t; ++s) acc += wrow[s] * vn[s * 256 + c];
        const float sv = acc + b_s[g * 128 + t];
        bf16_t* p = uz + (size_t)(t0 + t) * D + c0 + c;
        *p = (bf16_t)f2bf(bf2f(*p) * sv);
    }
}
__device__ __forceinline__ void naive_kv_unit(const Frame& F, const Args& a, int unit) {
    unsigned char* ws = a.ws;
    const int n = unit & 31, h = (unit >> 5) & 7, b = unit >> 8;
    const int t0 = b * SEQ + n * CH;
    LAS float* kw = (LAS float*)F.lds;
    LAS bf16_t* vs = (LAS bf16_t*)(F.lds + 65536);
    const bf16_t* kg = (const bf16_t*)(ws + WS_K);
    const bf16_t* rvT = (const bf16_t*)(ws + WS_RVT) + (size_t)((b * NCH + n) * 2048 + h * 256) * CH;
    bf16_t* kvT = (bf16_t*)(ws + WS_KVT) + (size_t)((b * 8 + h) * NCH + n) * (256 * 128);
    const float lg = a.lg2[h];
    __syncthreads();
    for (int i = F.tid; i < 128 * 128; i += 512) { const int s = i >> 7, d = i & 127; kw[i] = bf2f(kg[(size_t)(t0 + s) * 1024 + h * 128 + d]) * __builtin_amdgcn_exp2f(lg * (float)(127 - s)); }
    for (int i = F.tid; i < 256 * 128; i += 512) vs[i] = rvT[i];
    __syncthreads();
    const int d = F.tid & 127, eq = F.tid >> 7;
    for (int j0 = 0; j0 < 64; j0 += 8) {
        float acc[8];
#pragma unroll
        for (int j = 0; j < 8; ++j) acc[j] = 0.f;
        for (int s = 0; s < 128; ++s) { const float kv = kw[s * 128 + d];
#pragma unroll
            for (int j = 0; j < 8; ++j) acc[j] += kv * bf2f(vs[(eq * 64 + j0 + j) * 128 + s]); }
#pragma unroll
        for (int j = 0; j < 8; ++j) kvT[(size_t)(eq * 64 + j0 + j) * 128 + d] = (bf16_t)f2bf(acc[j]);
    }
}
__device__ __forceinline__ void scan_phase(const Frame& F, const Args& a) {
    unsigned char* ws = a.ws;
    const int gt = F.vcu * 512 + F.tid, NT = F.G * 512;
    for (int v = gt; v < 32 * 32768 / 8; v += NT) {
        const int bh = v >> 12, off = (v & 4095) * 8;
        const float cd = __builtin_amdgcn_exp2f(a.lg2[bh & 7] * 128.0f);
        const bf16_t* src = (const bf16_t*)(ws + WS_KVT) + (size_t)bh * NCH * 32768 + off;
        bf16_t* dst = (bf16_t*)(ws + WS_RT) + (size_t)bh * NCH * 32768 + off;
        float R[8];
#pragma unroll
        for (int j = 0; j < 8; ++j) R[j] = 0.f;
        for (int n0 = 0; n0 < NCH; n0 += 8) {
            u32x4 kvv[8];
#pragma unroll
            for (int j = 0; j < 8; ++j) kvv[j] = *(const u32x4*)(src + (size_t)(n0 + j) * 32768);
#pragma unroll
            for (int j = 0; j < 8; ++j) { const u32x4 kv = kvv[j];
                u32x4 o; o.x = pk2(R[0], R[1]); o.y = pk2(R[2], R[3]); o.z = pk2(R[4], R[5]); o.w = pk2(R[6], R[7]);
                *(u32x4*)(dst + (size_t)(n0 + j) * 32768) = o;
                R[0] = R[0] * cd + bflo(kv.x); R[1] = R[1] * cd + bfhi(kv.x); R[2] = R[2] * cd + bflo(kv.y); R[3] = R[3] * cd + bfhi(kv.y);
                R[4] = R[4] * cd + bflo(kv.z); R[5] = R[5] * cd + bfhi(kv.z); R[6] = R[6] * cd + bflo(kv.w); R[7] = R[7] * cd + bfhi(kv.w); }
        }
    }
}
__device__ __forceinline__ void naive_ret_unit(const Frame& F, const Args& a, int unit) {
    unsigned char* ws = a.ws;
    const int n = unit & 31, h = (unit >> 5) & 7, b = unit >> 8;
    const int t0 = b * SEQ + n * CH;
    constexpr int RS = 130;
    LAS bf16_t* qs = (LAS bf16_t*)F.lds;
    LAS bf16_t* ks = qs + 128 * RS;
    LAS bf16_t* ps = ks + 128 * RS;
    LAS bf16_t* rs_ = ps + 128 * RS;
    LAS float* st = (LAS float*)(rs_ + 128 * RS);
    const bf16_t* qg = (const bf16_t*)(ws + WS_Q); const bf16_t* kg = (const bf16_t*)(ws + WS_K);
    const bf16_t* rvT = (const bf16_t*)(ws + WS_RVT) + (size_t)((b * NCH + n) * 2048 + h * 256) * CH;
    const bf16_t* RT = (const bf16_t*)(ws + WS_RT) + (size_t)((b * 8 + h) * NCH + n) * (256 * 128);
    bf16_t* rz = (bf16_t*)(ws + WS_RZ);
    float* oscr = (float*)(ws + WS_SCR) + (size_t)blockIdx.x * (128 * 256);
    const float lg = a.lg2[h];
    __syncthreads();
    for (int i = F.tid; i < 128 * 128; i += 512) { const int r = i >> 7, d = i & 127;
        qs[r * RS + d] = qg[(size_t)(t0 + r) * 1024 + h * 128 + d]; ks[r * RS + d] = kg[(size_t)(t0 + r) * 1024 + h * 128 + d]; }
    if (F.tid < 256) st[F.tid] = 0.f;
    __syncthreads();
    { const int t = F.tid >> 2;
      for (int j = 0; j < 32; ++j) { const int s = (F.tid & 3) + 4 * j; float acc = 0.f;
          if (s <= t) { for (int d = 0; d < 128; ++d) acc += bf2f(qs[t * RS + d]) * bf2f(ks[s * RS + d]); acc *= __builtin_amdgcn_exp2f(lg * (float)(t - s)); }
          ps[t * RS + s] = (bf16_t)f2bf(acc); } }
    __syncthreads();
    const int e = F.tid & 127, th = F.tid >> 7;
    for (int eh = 0; eh < 2; ++eh) {
        for (int i = F.tid; i < 128 * 128; i += 512) { const int r = i >> 7, c = i & 127; ks[r * RS + c] = rvT[(size_t)(eh * 128 + r) * 128 + c]; rs_[r * RS + c] = RT[(size_t)(eh * 128 + r) * 128 + c]; }
        __syncthreads();
        for (int t = th; t < 128; t += 4) {
            float inner = 0.f, cross = 0.f;
            for (int s = 0; s <= t; ++s) inner += bf2f(ps[t * RS + s]) * bf2f(ks[e * RS + s]);
            for (int d = 0; d < 128; ++d) cross += bf2f(qs[t * RS + d]) * bf2f(rs_[e * RS + d]);
            const float o = inner + cross * __builtin_amdgcn_exp2f(lg * (float)(t + 1));
            oscr[t * 256 + eh * 128 + e] = o;
            const float s1 = wave_sum(o), s2 = wave_sum(o * o);
            if (F.lane == 0) { atomicAdd((float*)&st[t * 2], s1); atomicAdd((float*)&st[t * 2 + 1], s2); }
        }
        __syncthreads();
    }
    for (int eh = 0; eh < 2; ++eh)
        for (int t = th; t < 128; t += 4) {
            const float mean = st[t * 2] * (1.0f / 256.0f); float var = st[t * 2 + 1] * (1.0f / 256.0f) - mean * mean; var = var > 0.f ? var : 0.f;
            const float rstd = 1.0f / sqrtf(var + LN_EPS);
            const float o = oscr[t * 256 + eh * 128 + e];
            bf16_t* p = rz + (size_t)(t0 + t) * D + h * 256 + eh * 128 + e;
            *p = (bf16_t)f2bf((o - mean) * rstd * bf2f(*p));
        }
}

#define MFMA16(X, Y, C) __builtin_amdgcn_mfma_f32_16x16x32_bf16((X), (Y), (C), 0, 0, 0)
__device__ __forceinline__ bf16x8 ldfrag(const bf16_t* p) { return *(const bf16x8*)p; }
__device__ __forceinline__ bf16x8 pack8(const float (&v)[8]) { u32x4 w; w.x = pk2(v[0], v[1]); w.y = pk2(v[2], v[3]); w.z = pk2(v[4], v[5]); w.w = pk2(v[6], v[7]); return __builtin_bit_cast(bf16x8, w); }
__device__ __forceinline__ void unpack8(bf16x8 f, float (&v)[8]) { const u32x4 w = __builtin_bit_cast(u32x4, f); v[0] = bflo(w.x); v[1] = bfhi(w.x); v[2] = bflo(w.y); v[3] = bfhi(w.y); v[4] = bflo(w.z); v[5] = bfhi(w.z); v[6] = bflo(w.w); v[7] = bfhi(w.w); }

__device__ __forceinline__ void gate_task(const Args& a, int task, int lane) {
    unsigned char* ws = a.ws;
    const int w = task & 7, unit = task >> 3, g = unit & 7, n = (unit >> 3) & 31, b = unit >> 8;
    const int fr = lane & 15, fq = lane >> 4;
    const int t0 = b * SEQ + n * CH, cw = g * 256 + w * 32;
    const bf16_t* vTb = (const bf16_t*)(ws + WS_VT) + ((size_t)(b * NCH + n) * 2048 + cw) * CH;
    const float* vstat = (const float*)(ws + WS_VSTAT) + (size_t)t0 * 2;
    const bf16_t* wsm = (const bf16_t*)(ws + WS_WSM) + (size_t)g * CH * CH;
    const float* c2t = (const float*)(ws + WS_C2) + g * CH; const float* bst = a.in[6] + g * CH;
    bf16_t* uz = (bf16_t*)(ws + WS_UZ);
    bf16x8 xf[2][4];
    const int xrow = 8 * (fr >> 2) + (fr & 3);
#pragma unroll
    for (int kk = 0; kk < 4; ++kk) {
        float mu[8], rs[8];
        const f32x4* sp = (const f32x4*)(vstat + (size_t)(32 * kk + 8 * fq) * 2);
#pragma unroll
        for (int h2 = 0; h2 < 4; ++h2) { const f32x4 v = sp[h2];
            { const float m = v[0] * (1.0f / 2048.0f); float var = v[1] * (1.0f / 2048.0f) - m * m; var = var > 0.f ? var : 0.f; mu[2 * h2] = m; rs[2 * h2] = 1.0f / sqrtf(var + LN_EPS); }
            { const float m = v[2] * (1.0f / 2048.0f); float var = v[3] * (1.0f / 2048.0f) - m * m; var = var > 0.f ? var : 0.f; mu[2 * h2 + 1] = m; rs[2 * h2 + 1] = 1.0f / sqrtf(var + LN_EPS); } }
#pragma unroll
        for (int aa = 0; aa < 2; ++aa) {
            float v[8]; unpack8(ldfrag(vTb + (size_t)(xrow + 4 * aa) * CH + 32 * kk + 8 * fq), v);
#pragma unroll
            for (int q = 0; q < 8; ++q) v[q] = (v[q] - mu[q]) * rs[q];
            xf[aa][kk] = pack8(v);
        }
    }
    float lg8[8], lb8[8];
    { const f32x4* gp = (const f32x4*)(a.in[3] + cw + 8 * fq); const f32x4* bp = (const f32x4*)(a.in[4] + cw + 8 * fq);
      const f32x4 g0 = gp[0], g1 = gp[1], b0 = bp[0], b1 = bp[1];
#pragma unroll
      for (int j = 0; j < 4; ++j) { lg8[j] = g0[j]; lg8[4 + j] = g1[j]; lb8[j] = b0[j]; lb8[4 + j] = b1[j]; } }
#pragma unroll
    for (int tt = 0; tt < 8; ++tt) {
        const int t = 16 * tt + fr;
        f32x4 acc0 = (f32x4){0.f, 0.f, 0.f, 0.f}, acc1 = (f32x4){0.f, 0.f, 0.f, 0.f};
#pragma unroll
        for (int kk = 0; kk < 4; ++kk) if (kk <= (tt >> 1)) {
            const bf16x8 yf = ldfrag(wsm + (size_t)t * CH + 32 * kk + 8 * fq);
            acc0 = MFMA16(xf[0][kk], yf, acc0); acc1 = MFMA16(xf[1][kk], yf, acc1);
        }
        const float c2 = c2t[t], bs = bst[t];
        bf16_t* up = uz + (size_t)(t0 + t) * D + cw + 8 * fq;
        float u8[8]; unpack8(*(const bf16x8*)up, u8);
#pragma unroll
        for (int r = 0; r < 4; ++r) { u8[r] *= lg8[r] * acc0[r] + lb8[r] * c2 + bs; u8[4 + r] *= lg8[4 + r] * acc1[r] + lb8[4 + r] * c2 + bs; }
        *(bf16x8*)up = pack8(u8);
    }
}

__device__ __forceinline__ void kv_task(const Args& a, int task, int lane) {
    unsigned char* ws = a.ws;
    const int w = task & 7, unit = task >> 3, n = unit & 31, h = (unit >> 5) & 7, b = unit >> 8;
    const int fr = lane & 15, fq = lane >> 4;
    const bf16_t* rvTb = (const bf16_t*)(ws + WS_RVT) + ((size_t)(b * NCH + n) * 2048 + h * 256 + 32 * w) * CH;
    const bf16_t* kTb = (const bf16_t*)(ws + WS_KT) + ((size_t)(b * NCH + n) * 1024 + h * 128) * CH;
    bf16_t* kvT = (bf16_t*)(ws + WS_KVT) + (size_t)((b * 8 + h) * NCH + n) * (256 * 128) + (size_t)(32 * w) * 128;
    const float lg = a.lg2[h];
    bf16x8 yf[2][4];
#pragma unroll
    for (int kk = 0; kk < 4; ++kk) {
        float wd[8];
#pragma unroll
        for (int q = 0; q < 8; ++q) wd[q] = __builtin_amdgcn_exp2f(lg * (float)(127 - (32 * kk + 8 * fq + q)));
#pragma unroll
        for (int et = 0; et < 2; ++et) { float v[8]; unpack8(ldfrag(rvTb + (size_t)(16 * et + fr) * CH + 32 * kk + 8 * fq), v);
#pragma unroll
            for (int q = 0; q < 8; ++q) v[q] *= wd[q];
            yf[et][kk] = pack8(v); }
    }
    const int xrow = 8 * (fr >> 2) + (fr & 3);
#pragma unroll
    for (int dp = 0; dp < 4; ++dp) {
        f32x4 acc[2][2];
#pragma unroll
        for (int aa = 0; aa < 2; ++aa)
#pragma unroll
            for (int et = 0; et < 2; ++et) acc[aa][et] = (f32x4){0.f, 0.f, 0.f, 0.f};
#pragma unroll
        for (int kk = 0; kk < 4; ++kk)
#pragma unroll
            for (int aa = 0; aa < 2; ++aa) {
                const bf16x8 xf = ldfrag(kTb + (size_t)(32 * dp + xrow + 4 * aa) * CH + 32 * kk + 8 * fq);
                acc[aa][0] = MFMA16(xf, yf[0][kk], acc[aa][0]); acc[aa][1] = MFMA16(xf, yf[1][kk], acc[aa][1]);
            }
#pragma unroll
        for (int et = 0; et < 2; ++et) {
            const float v[8] = {acc[0][et][0], acc[0][et][1], acc[0][et][2], acc[0][et][3], acc[1][et][0], acc[1][et][1], acc[1][et][2], acc[1][et][3]};
            *(bf16x8*)(kvT + (size_t)(16 * et + fr) * 128 + 32 * dp + 8 * fq) = pack8(v);
        }
    }
}

__device__ __forceinline__ void ret_task(const Args& a, int task, int lane, int wave, LAS unsigned char* lds) {
    unsigned char* ws = a.ws;
    const int w = task & 7, unit = task >> 3, n = unit & 31, h = (unit >> 5) & 7, b = unit >> 8;
    const int fr = lane & 15, fq = lane >> 4;
    const int t0 = b * SEQ + n * CH, tl = 16 * w + fr;
    const bf16_t* qg = (const bf16_t*)(ws + WS_Q) + (size_t)(t0 + tl) * 1024 + h * 128;
    const bf16_t* kg = (const bf16_t*)(ws + WS_K) + (size_t)t0 * 1024 + h * 128;
    const bf16_t* rvTb = (const bf16_t*)(ws + WS_RVT) + ((size_t)(b * NCH + n) * 2048 + h * 256) * CH;
    const bf16_t* RTb = (const bf16_t*)(ws + WS_RT) + (size_t)((b * 8 + h) * NCH + n) * (256 * 128);
    bf16_t* rzp = (bf16_t*)(ws + WS_RZ) + (size_t)(t0 + tl) * D + h * 256;
    const float lg = a.lg2[h];
    const int xrow = 8 * (fr >> 2) + (fr & 3);
    const int nsb = (w >> 1) + 1;
    bf16x8 qf[4];
#pragma unroll
    for (int kk = 0; kk < 4; ++kk) qf[kk] = ldfrag(qg + 32 * kk + 8 * fq);
    bf16x8 pf[4];
#pragma unroll
    for (int sb = 0; sb < 4; ++sb) {
        pf[sb] = (bf16x8){0, 0, 0, 0, 0, 0, 0, 0};
        if (sb < nsb) {
            f32x4 s0 = (f32x4){0.f, 0.f, 0.f, 0.f}, s1 = (f32x4){0.f, 0.f, 0.f, 0.f};
#pragma unroll
            for (int kk = 0; kk < 4; ++kk) {
                const bf16x8 k0 = ldfrag(kg + (size_t)(32 * sb + xrow) * 1024 + 32 * kk + 8 * fq), k1 = ldfrag(kg + (size_t)(32 * sb + xrow + 4) * 1024 + 32 * kk + 8 * fq);
                s0 = MFMA16(k0, qf[kk], s0); s1 = MFMA16(k1, qf[kk], s1);
            }
            float p[8];
#pragma unroll
            for (int r = 0; r < 4; ++r) {
                const int sa = 32 * sb + 8 * fq + r, sbb = sa + 4;
                p[r] = (sa <= tl) ? s0[r] * __builtin_amdgcn_exp2f(lg * (float)(tl - sa)) : 0.f;
                p[4 + r] = (sbb <= tl) ? s1[r] * __builtin_amdgcn_exp2f(lg * (float)(tl - sbb)) : 0.f;
            }
            pf[sb] = pack8(p);
        }
        asm volatile("" ::: "memory");
    }
    const float cdec = __builtin_amdgcn_exp2f(lg * (float)(tl + 1));
    LAS f32x4* ol = (LAS f32x4*)(lds + wave * 16384) + lane;
    float sum = 0.f, sq = 0.f;
#pragma unroll 1
    for (int p = 0; p < 8; ++p) {
        f32x4 ai0 = (f32x4){0.f, 0.f, 0.f, 0.f}, ai1 = ai0, ac0 = ai0, ac1 = ai0;
        const bf16_t* vr = rvTb + (size_t)(32 * p + xrow) * CH + 8 * fq;
        const bf16_t* rr = RTb + (size_t)(32 * p + xrow) * 128 + 8 * fq;
#pragma unroll
        for (int sb = 0; sb < 4; ++sb) if (sb < nsb) {
            ai0 = MFMA16(ldfrag(vr + 32 * sb), pf[sb], ai0); ai1 = MFMA16(ldfrag(vr + 4 * CH + 32 * sb), pf[sb], ai1);
        }
#pragma unroll
        for (int kk = 0; kk < 4; ++kk) {
            ac0 = MFMA16(ldfrag(rr + 32 * kk), qf[kk], ac0); ac1 = MFMA16(ldfrag(rr + 4 * 128 + 32 * kk), qf[kk], ac1);
        }
        const f32x4 o0 = ai0 + ac0 * cdec, o1 = ai1 + ac1 * cdec;
        ol[(2 * p) * 64] = o0; ol[(2 * p + 1) * 64] = o1;
#pragma unroll
        for (int r = 0; r < 4; ++r) { sum += o0[r] + o1[r]; sq += o0[r] * o0[r] + o1[r] * o1[r]; }
    }
    sum += __shfl_xor(sum, 16); sum += __shfl_xor(sum, 32); sq += __shfl_xor(sq, 16); sq += __shfl_xor(sq, 32);
    const float mean = sum * (1.0f / 256.0f); float var = sq * (1.0f / 256.0f) - mean * mean; var = var > 0.f ? var : 0.f;
    const float rstd = 1.0f / sqrtf(var + LN_EPS);
#pragma unroll 1
    for (int p = 0; p < 8; ++p) {
        bf16_t* zp = rzp + 32 * p + 8 * fq;
        const f32x4 o0 = ol[(2 * p) * 64], o1 = ol[(2 * p + 1) * 64];
        float z[8]; unpack8(*(const bf16x8*)zp, z);
#pragma unroll
        for (int r = 0; r < 4; ++r) { z[r] *= (o0[r] - mean) * rstd; z[4 + r] *= (o1[r] - mean) * rstd; }
        *(bf16x8*)zp = pack8(z);
    }
}

__device__ __forceinline__ void ln_phase(const Frame& F, const Args& a) {
    const int gw = F.vcu * 8 + F.wave, NGW = F.G * 8;
    const float* g = a.in[10]; const float* bb = a.in[11];
    for (int m = gw; m < M; m += NGW) {
        f32x4* row = (f32x4*)(a.out + (size_t)m * D) + F.lane;
        f32x4 v[8]; float s = 0.f;
#pragma unroll
        for (int j = 0; j < 8; ++j) { v[j] = row[64 * j]; s += (v[j][0] + v[j][1]) + (v[j][2] + v[j][3]); }
        const float mean = wave_sum(s) * (1.0f / D); float s2 = 0.f;
#pragma unroll
        for (int j = 0; j < 8; ++j) { v[j] = v[j] - mean; s2 += (v[j][0] * v[j][0] + v[j][1] * v[j][1]) + (v[j][2] * v[j][2] + v[j][3] * v[j][3]); }
        const float rstd = 1.0f / sqrtf(wave_sum(s2) * (1.0f / D) + LN_EPS);
#pragma unroll
        for (int j = 0; j < 8; ++j) { const f32x4 gg = *((const f32x4*)g + F.lane + 64 * j), bv = *((const f32x4*)bb + F.lane + 64 * j); row[64 * j] = v[j] * rstd * gg + bv; }
    }
}

__global__ void __launch_bounds__(512, 2) mk_fwd(Args args) {
    extern __shared__ __attribute__((aligned(16))) unsigned char lds_raw[];
    Frame F;
    F.lds = (LAS unsigned char*)lds_raw;
    F.tid = threadIdx.x; F.lane = F.tid & 63; F.wave = __builtin_amdgcn_readfirstlane(F.tid >> 6);
    F.G = gridDim.x; { const int bx = blockIdx.x; F.vcu = (F.G % 8 == 0) ? (bx % 8) * (F.G / 8) + bx / 8 : bx; }
    unsigned char* ws = args.ws;
    const int lo = args.ph_lo, hi = args.ph_hi;
#define IN(k) (lo <= (k) && (k) < hi)
#define BOTH(k) (IN(k) && IN((k) + 1))
#if MK_XCD_BARRIER
    volatile LAS unsigned* MISC = (volatile LAS unsigned*)(F.lds + 131072 + 320);
    if (F.tid < 32) MISC[F.tid] = 0u;
    __syncthreads();
    XcdBarrier xbar; xbar.bar = (unsigned*)(ws + WS_CTL) + CW_BAR; xbar.x = 0; xbar.st = nullptr;
    if (hi - lo > 1) xbar = xcd_barrier_post((unsigned*)(ws + WS_CTL) + CW_BAR, MISC + 8);
#define GRID_BAR() do { xcd_barrier(xbar); } while (0)
#else
#define GRID_BAR() do { cg::this_grid().sync(); } while (0)
#endif

    if (IN(0)) { p0_prologue(F, args); if (BOTH(0)) GRID_BAR(); }
    if (IN(1)) {
        OrderP1 S{F.G, (int)blockIdx.x, (const char*)(ws + WS_XB), (const char*)(ws + WS_WIN)};
        EpiP1 E{ws, (bf16_t*)args.out, args.in[2]};
        pg8::gemm_phase<EpiP1, OrderP1>(F.lds, S, E);
        if (BOTH(1)) GRID_BAR();
    }
    if (IN(2)) {
#if MIX_GATE
        for (int task = F.vcu * 8 + F.wave; task < 8192; task += F.G * 8) gate_task(args, task, F.lane);
#else
        for (int u = F.vcu; u < 1024; u += F.G) naive_gate_unit(F, args, u);
#endif
#if MIX_KV
        for (int task = F.vcu * 8 + F.wave; task < 8192; task += F.G * 8) kv_task(args, task, F.lane);
#else
        for (int u = F.vcu; u < 1024; u += F.G) naive_kv_unit(F, args, u);
#endif
        __syncthreads();
        if (BOTH(2)) GRID_BAR();
    }
    if (IN(3)) { scan_phase(F, args); if (BOTH(3)) GRID_BAR(); }
    if (IN(4)) {
#if MIX_RET
        for (int task = F.vcu * 8 + F.wave; task < 8192; task += F.G * 8) ret_task(args, task, F.lane, F.wave, F.lds);
#else
        for (int u = F.vcu; u < 1024; u += F.G) naive_ret_unit(F, args, u);
#endif
        __syncthreads();
        if (BOTH(4)) GRID_BAR();
    }
    if (IN(5)) {
        OrderP3 S{F.G, (int)blockIdx.x, (const char*)(ws + WS_UZ), (const char*)(ws + WS_RZ), (const char*)(ws + WS_WOA), (const char*)(ws + WS_WOB)};
        EpiP3 E{(const bf16_t*)args.out, (const bf16_t*)args.out + (size_t)M * D, (bf16_t*)(ws + WS_MB)};
        pg8::gemm_phase<EpiP3, OrderP3>(F.lds, S, E);
        if (BOTH(5)) GRID_BAR();
    }
    if (IN(6)) {
        OrderP4 S{F.G, (int)blockIdx.x, (const char*)(ws + WS_MB), (const char*)(ws + WS_WOUT)};
        EpiP4 E{args.in[0], args.out};
        pg8::gemm_phase<EpiP4, OrderP4>(F.lds, S, E);
        if (BOTH(6)) GRID_BAR();
    }
    if (IN(7)) { ln_phase(F, args); }
#undef IN
#undef BOTH
}

extern "C" void kernel_launch(void* const* d_in, const int* in_sizes, int n_in, void* d_out, int out_size, void* d_ws, size_t ws_size, hipStream_t stream) {
    static int grid = 0;
    if (grid == 0) {
        if (n_in != 12 || out_size != M * D || ws_size < WS_END) { fprintf(stderr, "kernel_launch: unexpected shapes (n_in %d, out %d, ws %zu)\n", n_in, out_size, ws_size); grid = -1; return; }
        int dev = 0, cus = 0, per_cu = 0;
        if (hipGetDevice(&dev) != hipSuccess || hipDeviceGetAttribute(&cus, hipDeviceAttributeMultiprocessorCount, dev) != hipSuccess) { grid = -1; return; }
        if (hipFuncSetAttribute((const void*)mk_fwd, hipFuncAttributeMaxDynamicSharedMemorySize, LDS_BYTES) != hipSuccess) { fprintf(stderr, "kernel_launch: hipFuncSetAttribute failed\n"); grid = -1; return; }
        if (hipOccupancyMaxActiveBlocksPerMultiprocessor(&per_cu, (const void*)mk_fwd, 512, LDS_BYTES) != hipSuccess || per_cu < 1) { fprintf(stderr, "kernel_launch: occupancy query says %d blocks per CU\n", per_cu); grid = -1; return; }
        (void)hipGetLastError();
        grid = cus;
    }
    if (grid < 0) return;
    Args a{};
    for (int i = 0; i < 12; ++i) a.in[i] = (const float*)d_in[i];
    a.out = (float*)d_out; a.ws = (unsigned char*)d_ws;
    for (int j = 0; j < 64; ++j) a.freq[j] = (float)std::pow(10000.0, -(double)(2 * j) / 128.0);
    for (int h = 0; h < 8; ++h) a.lg2[h] = (float)(std::log1p(-std::exp2(-5.0 - (double)h)) / std::log(2.0));
#if MK_N_LAUNCHES == 1 && MK_XCD_BARRIER
    a.ph_lo = 0; a.ph_hi = 8;
    if (hipMemsetAsync((char*)d_ws + WS_CTL, 0, CTL_ZERO_BYTES, stream) != hipSuccess) { fprintf(stderr, "kernel_launch: memset failed\n"); return; }
    hipLaunchKernelGGL(mk_fwd, dim3(grid), dim3(512), LDS_BYTES, stream, a);
#elif MK_N_LAUNCHES == 1
    a.ph_lo = 0; a.ph_hi = 8;
    void* kargs[] = {&a};
    hipError_t e = hipLaunchCooperativeKernel((const void*)mk_fwd, dim3(grid), dim3(512), kargs, LDS_BYTES, stream);
    if (e != hipSuccess) fprintf(stderr, "kernel_launch: cooperative launch failed: %s (grid %d)\n", hipGetErrorString(e), grid);
#else
    for (int p = 0; p < 8; ++p) { a.ph_lo = p; a.ph_hi = p + 1; hipLaunchKernelGGL(mk_fwd, dim3(grid), dim3(512), LDS_BYTES, stream, a); }
#endif
}
```

```cpp
#include <hip/hip_runtime.h>
#include <hip/hip_cooperative_groups.h>
#include <cstdio>
#include <cstdint>
#include <cmath>
namespace cg = cooperative_groups;

#ifndef MK_N_LAUNCHES
#define MK_N_LAUNCHES 1
#endif

#ifndef MIX_GATE
#define MIX_GATE 1
#endif
#ifndef MIX_KV
#define MIX_KV 1
#endif
#ifndef MIX_RET
#define MIX_RET 1
#endif
#define LAS __attribute__((address_space(3)))
#define GAS __attribute__((address_space(1)))
typedef unsigned short bf16_t;
typedef short bf16x8 __attribute__((ext_vector_type(8)));
typedef float f32x4 __attribute__((ext_vector_type(4)));
typedef float f32x2 __attribute__((ext_vector_type(2)));
typedef unsigned u32x4 __attribute__((ext_vector_type(4)));
typedef unsigned u32x2 __attribute__((ext_vector_type(2)));

constexpr int M = 16384, D = 2048, NIN = 16384, SEQ = 4096, NCH = 32  , CH = 128;
constexpr int NHEAD = 8, DK = 128, DV = 256;
constexpr float LN_EPS = 1e-5f;
constexpr float DN_ALPHA = 1.189207115002721f;
constexpr float K_SCALE = 0.08838834764831845f;

constexpr size_t MiB = 1u << 20;
constexpr size_t WS_CTL = 0;
constexpr size_t WS_WOA = 1 * MiB, WS_WOB = 9 * MiB, WS_WOUT = 17 * MiB;
constexpr size_t WS_CS = 25 * MiB;
constexpr size_t WS_WSM = 27 * MiB;
constexpr size_t WS_C2 = 27 * MiB + 512 * 1024;
constexpr size_t WS_VSTAT = 28 * MiB;
constexpr size_t WS_XB = 32 * MiB, WS_WIN = 96 * MiB;
constexpr size_t WS_UZ = 160 * MiB, WS_VT = 224 * MiB, WS_Q = 288 * MiB, WS_K = 320 * MiB, WS_RVT = 352 * MiB, WS_RZ = 416 * MiB;
constexpr size_t WS_KVT = 32 * MiB, WS_RT = 96 * MiB;
constexpr size_t WS_MB = 224 * MiB;
constexpr size_t WS_SCR = 480 * MiB;
constexpr size_t WS_KT = 480 * MiB;
constexpr size_t WS_END = 512 * MiB;

constexpr int LDS_BYTES = 147456;

__device__ __forceinline__ unsigned f2bf(float f) { unsigned u = __builtin_bit_cast(unsigned, f); return (u + 0x7fffu + ((u >> 16) & 1u)) >> 16; }
typedef __bf16 hwbf16x2 __attribute__((ext_vector_type(2)));
__device__ __forceinline__ unsigned pk2(float lo, float hi) { const f32x2 v = {lo, hi}; const hwbf16x2 b = __builtin_convertvector(v, hwbf16x2); return __builtin_bit_cast(unsigned, b); }
__device__ __forceinline__ float bf2f(unsigned short b) { return __builtin_bit_cast(float, ((unsigned)b) << 16); }
__device__ __forceinline__ float bflo(unsigned w) { return __builtin_bit_cast(float, w << 16); }
__device__ __forceinline__ float bfhi(unsigned w) { return __builtin_bit_cast(float, w & 0xffff0000u); }
__device__ __forceinline__ float fast_sigmoid(float x) { return __builtin_amdgcn_rcpf(1.0f + __builtin_amdgcn_exp2f(-1.4426950408889634f * x)); }
__device__ __forceinline__ float silu_f(float x) { return x * fast_sigmoid(x); }
__device__ __forceinline__ float gelu_tanh_f(float x) {
    return x * __builtin_amdgcn_rcpf(1.0f + __builtin_amdgcn_exp2f(x * (-2.302208198f - 0.10294324f * x * x)));
}
__device__ __forceinline__ float gelu_silu_f(float u, float z) {
    const float e1 = __builtin_amdgcn_exp2f(u * (-2.302208198f - 0.10294324f * u * u)), e2 = __builtin_amdgcn_exp2f(-1.4426950408889634f * z);
    return (u * z) * __builtin_amdgcn_rcpf((1.0f + e1) * (1.0f + e2));
}
__device__ __forceinline__ float wave_sum(float v) {
#pragma unroll
    for (int o = 1; o < 64; o <<= 1) v += __shfl_xor(v, o);
    return v;
}
#define LDS_WAIT() asm volatile("s_waitcnt lgkmcnt(0)" ::: "memory")
#define VM_WAIT() asm volatile("s_waitcnt vmcnt(0)" ::: "memory")

#ifndef PG8_SP2
#define PG8_SP2 1
#endif
namespace pg8 {
constexpr int BM = 256, BK = 64, HALF = 128, HTB = HALF * BK * 2  , STAGE_BYTES = 8 * HTB, NXCD = 8, WGM = 8;
constexpr int KDIM = 2048;

__host__ __device__ __forceinline__ int lds_byte(int r, int c) { const int st = (r >> 4) * 2 + (c >> 5), rr = r & 15, cc = c & 31, ob = rr * 64 + cc * 2; return st * 1024 + (ob ^ (((ob >> 9) & 1) << 5)); }
__host__ __device__ __forceinline__ void stage_rc(int b, int& R, int& C) { const int st = b / 1024, sb = b % 1024, swz = sb ^ (((sb >> 9) & 1) << 5); R = (st >> 1) * 16 + swz / 64; C = (st & 1) * 32 + (swz % 64) / 2; }
__host__ __device__ __forceinline__ int perm32(int rho) { const int n = rho >> 4, i = rho & 15; return 8 * (i >> 2) + 4 * n + (i & 3); }

struct Unit { int pm, pn, kind; const char* a; const char* b; };

__device__ __forceinline__ void tile_of(int L, int nM, int nN, int& pm, int& pn) {
    const int nwg = nM * nN; int wgid = L;
    { const int q = nwg / NXCD, r = nwg % NXCD, xcd = wgid % NXCD, off = wgid / NXCD; wgid = (xcd < r ? xcd * (q + 1) : r * (q + 1) + (xcd - r) * q) + off; }
    const int nig = WGM * nN, gid = wgid / nig, fm = gid * WGM, gsz = (nM - fm) < WGM ? (nM - fm) : WGM;
    pm = fm + ((wgid % nig) % gsz); pn = (wgid % nig) / gsz;
}

template <class Epi, class Sched>
__device__ __forceinline__ void gemm_phase(LAS unsigned char* lds, const Sched& S, const Epi& E) {
    const int tid = threadIdx.x, wid = __builtin_amdgcn_readfirstlane(tid >> 6), lane = tid & 63, wr = wid >> 2, wc = wid & 3, fr = lane & 15, fq = lane >> 4;
    constexpr int K = KDIM, nt = K / BK;
    unsigned voffA[2], voffB[2];
#pragma unroll
    for (int i = 0; i < 2; ++i) { int R, C; stage_rc(tid * 16 + i * 8192, R, C); const int Rb = Epi::PERM ? ((R & ~31) + perm32(R & 31)) : R;
        voffA[i] = (unsigned)(R * K + C) * 2u; voffB[i] = (unsigned)(Rb * K + C) * 2u; }
    constexpr size_t kstep = (size_t)(BK * 2);
    constexpr size_t hstep = (size_t)HALF * K * 2;
    const unsigned ldsw = (unsigned)wid * 1024u;
    const int aoff = lds_byte(wr * 64 + fr, fq * 8), boff = lds_byte(wc * 32 + fr, fq * 8);
#define PG8_SA(b, h) (((b) * 2 + (h)) * HTB)
#define PG8_SB(b, h) ((4 + (b) * 2 + (h)) * HTB)
#define PG8_STAGE(bufoff, gbase, voff) do { _Pragma("unroll") for (int _i = 0; _i < 2; ++_i) \
        __builtin_amdgcn_global_load_lds((const unsigned*)((const char*)(gbase) + (voff)[_i]), (LAS unsigned*)(lds + (bufoff) + ldsw + _i * 8192), 16, 0, 0); } while (0)
#define PG8_LDA(dst, b, h) do { _Pragma("unroll") for (int m = 0; m < 4; ++m) _Pragma("unroll") for (int k = 0; k < 2; ++k) dst[m][k] = *(const LAS bf16x8*)(lds + PG8_SA(b, h) + aoff + m * 2048 + k * 1024); } while (0)
#define PG8_LDB(dst, b, h) do { _Pragma("unroll") for (int n = 0; n < 2; ++n) _Pragma("unroll") for (int k = 0; k < 2; ++k) dst[n][k] = *(const LAS bf16x8*)(lds + PG8_SB(b, h) + boff + n * 2048 + k * 1024); } while (0)
#define PG8_MMA(ai, bj, At, Bt) do { __builtin_amdgcn_s_setprio(1); _Pragma("unroll") for (int m = 0; m < 4; ++m) _Pragma("unroll") for (int n = 0; n < 2; ++n) _Pragma("unroll") for (int k = 0; k < 2; ++k) \
        acc[ai][bj][m][n] = __builtin_amdgcn_mfma_f32_16x16x32_bf16(Bt[n][k], At[m][k], acc[ai][bj][m][n], 0, 0, 0); __builtin_amdgcn_s_setprio(0); } while (0)
#define PG8_WAIT_V(n) asm volatile("s_waitcnt vmcnt(" #n ")" ::: "memory")
#define PG8_WAIT_L(n) asm volatile("s_waitcnt lgkmcnt(" #n ")" ::: "memory")
#define PG8_BAR __builtin_amdgcn_s_barrier()
#define PG8_SCHED __builtin_amdgcn_sched_barrier(0)
    Unit cur, nxt; int ui = 0;
    if (!S.next(0, cur)) return;
    f32x4 acc[2][2][4][2];
#pragma unroll
    for (int a = 0; a < 2; ++a)
#pragma unroll
        for (int b = 0; b < 2; ++b)
#pragma unroll
            for (int m = 0; m < 4; ++m)
#pragma unroll
                for (int n = 0; n < 2; ++n) acc[a][b][m][n] = (f32x4){0.f, 0.f, 0.f, 0.f};
    bf16x8 At[4][2], B0[2][2], B1[2][2];
    const char* cA = cur.a; const char* cB = cur.b;
#if PG8_SP2
    PG8_STAGE(PG8_SB(0, 0), cB, voffB); PG8_STAGE(PG8_SB(0, 1), cB + hstep, voffB); PG8_STAGE(PG8_SA(0, 0), cA, voffA); PG8_STAGE(PG8_SA(0, 1), cA + hstep, voffA);
    if (wr == 1) PG8_BAR;
    PG8_WAIT_V(2); PG8_BAR;
    PG8_STAGE(PG8_SB(1, 0), cB + kstep, voffB); PG8_STAGE(PG8_SA(1, 0), cA + kstep, voffA); PG8_STAGE(PG8_SB(1, 1), cB + hstep + kstep, voffB);
    PG8_WAIT_V(6); PG8_BAR;
#else
    PG8_STAGE(PG8_SB(0, 0), cB, voffB); PG8_STAGE(PG8_SA(0, 0), cA, voffA); PG8_STAGE(PG8_SB(0, 1), cB + hstep, voffB); PG8_STAGE(PG8_SA(0, 1), cA + hstep, voffA);
    if (wr == 1) PG8_BAR;
    PG8_WAIT_V(4); PG8_BAR;
    PG8_STAGE(PG8_SB(1, 0), cB + kstep, voffB); PG8_STAGE(PG8_SA(1, 0), cA + kstep, voffA); PG8_STAGE(PG8_SB(1, 1), cB + hstep + kstep, voffB);
    PG8_WAIT_V(6); PG8_BAR;
#endif
    for (;;) {
        const bool has_next = S.next(ui + 1, nxt);
        const char* nA = has_next ? nxt.a : cA; const char* nB = has_next ? nxt.b : cB;
        for (int t = 0; t < nt; t += 2) {
            const bool last = (t == nt - 2);
            const char* a1 = cA + (size_t)(t + 1) * kstep;
            const char* a2 = last ? nA : cA + (size_t)(t + 2) * kstep; const char* b2 = last ? nB : cB + (size_t)(t + 2) * kstep;
            const char* a3 = a2 + kstep; const char* b3 = b2 + kstep;
#if PG8_SP2
            PG8_LDB(B0, 0, 0); PG8_LDB(B1, 0, 1); PG8_SCHED; PG8_LDA(At, 0, 0); PG8_STAGE(PG8_SA(1, 1), a1 + hstep, voffA);
            PG8_WAIT_V(8); PG8_WAIT_L(0); PG8_BAR; PG8_MMA(0, 0, At, B0); PG8_MMA(0, 1, At, B1); PG8_BAR; PG8_SCHED;
            PG8_LDA(At, 0, 1); PG8_STAGE(PG8_SB(0, 0), b2, voffB); PG8_STAGE(PG8_SB(0, 1), b2 + hstep, voffB); PG8_STAGE(PG8_SA(0, 0), a2, voffA);
            PG8_WAIT_V(8); PG8_WAIT_L(0); PG8_BAR; PG8_MMA(1, 0, At, B0); PG8_MMA(1, 1, At, B1); PG8_BAR; PG8_SCHED;
            PG8_LDB(B0, 1, 0); PG8_LDB(B1, 1, 1); PG8_SCHED; PG8_LDA(At, 1, 0); PG8_STAGE(PG8_SA(0, 1), a2 + hstep, voffA);
            PG8_WAIT_V(8); PG8_WAIT_L(0); PG8_BAR; PG8_MMA(0, 0, At, B0); PG8_MMA(0, 1, At, B1); PG8_BAR; PG8_SCHED;
            PG8_LDA(At, 1, 1); PG8_STAGE(PG8_SB(1, 0), b3, voffB); PG8_STAGE(PG8_SB(1, 1), b3 + hstep, voffB); PG8_STAGE(PG8_SA(1, 0), a3, voffA);
            PG8_WAIT_V(8); PG8_WAIT_L(0); PG8_BAR; PG8_MMA(1, 0, At, B0); PG8_MMA(1, 1, At, B1); PG8_BAR; PG8_SCHED;
        }
#else
            PG8_LDB(B0, 0, 0); PG8_SCHED; PG8_LDA(At, 0, 0); PG8_STAGE(PG8_SA(1, 1), a1 + hstep, voffA);
            PG8_WAIT_L(8); PG8_BAR; PG8_WAIT_L(0); PG8_MMA(0, 0, At, B0); PG8_BAR; PG8_SCHED;
            PG8_LDB(B1, 0, 1); PG8_STAGE(PG8_SB(0, 0), b2, voffB);
            PG8_BAR; PG8_WAIT_L(0); PG8_MMA(0, 1, At, B1); PG8_BAR;
            PG8_LDA(At, 0, 1); PG8_STAGE(PG8_SA(0, 0), a2, voffA);
            PG8_BAR; PG8_WAIT_L(0); PG8_MMA(1, 0, At, B0); PG8_BAR; PG8_SCHED;
            PG8_STAGE(PG8_SB(0, 1), b2 + hstep, voffB);
            PG8_WAIT_V(6); PG8_BAR; PG8_MMA(1, 1, At, B1); PG8_BAR;
            PG8_LDB(B0, 1, 0); PG8_SCHED; PG8_LDA(At, 1, 0); PG8_STAGE(PG8_SA(0, 1), a2 + hstep, voffA);
            PG8_WAIT_L(8); PG8_BAR; PG8_WAIT_L(0); PG8_MMA(0, 0, At, B0); PG8_BAR; PG8_SCHED;
            PG8_LDB(B1, 1, 1); PG8_STAGE(PG8_SB(1, 0), b3, voffB);
            PG8_BAR; PG8_WAIT_L(0); PG8_MMA(0, 1, At, B1); PG8_BAR;
            PG8_LDA(At, 1, 1); PG8_STAGE(PG8_SA(1, 0), a3, voffA);
            PG8_BAR; PG8_WAIT_L(0); PG8_MMA(1, 0, At, B0); PG8_BAR; PG8_SCHED;
            PG8_STAGE(PG8_SB(1, 1), b3 + hstep, voffB);
            PG8_WAIT_V(6); PG8_BAR; PG8_MMA(1, 1, At, B1); PG8_BAR;
        }
#endif
        E(acc, cur, wr, wc, fr, fq);
        if (!has_next) break;
#pragma unroll
        for (int a = 0; a < 2; ++a)
#pragma unroll
            for (int b = 0; b < 2; ++b)
#pragma unroll
                for (int m = 0; m < 4; ++m)
#pragma unroll
                    for (int n = 0; n < 2; ++n) acc[a][b][m][n] = (f32x4){0.f, 0.f, 0.f, 0.f};
        cur = nxt; cA = nA; cB = nB; ++ui;
    }
    PG8_WAIT_V(0);
    if (wr == 0) PG8_BAR;
    PG8_BAR;
#undef PG8_SA
#undef PG8_SB
#undef PG8_STAGE
#undef PG8_LDA
#undef PG8_LDB
#undef PG8_MMA
#undef PG8_WAIT_V
#undef PG8_WAIT_L
#undef PG8_BAR
#undef PG8_SCHED
}
}

struct Args {
    const float* in[12];
    float* out; unsigned char* ws;
    float freq[64];
    float lg2[8];
    int ph_lo, ph_hi;
};

enum { KIND_UZ = 0, KIND_V = 1, KIND_Q = 2, KIND_K = 3, KIND_RV = 4, KIND_RZ = 5, KIND_GA = 6, KIND_GB = 7 };
__host__ __device__ __forceinline__ int p1_kind(int pn) { return pn < 16 ? KIND_UZ : pn < 24 ? KIND_V : pn < 28 ? KIND_Q : pn < 32 ? KIND_K : pn < 40 ? KIND_RV : pn < 48 ? KIND_RZ : pn < 56 ? KIND_GA : KIND_GB; }
__host__ __device__ __forceinline__ int p1_col(int rho) {
    const int tile = rho >> 8, w = rho & 255;
    if (tile < 16) return (w < 128) ? 128 * tile + w : 4096 + 128 * tile + (w - 128);
    if (tile < 24) return 2048 + 256 * (tile - 16) + w;
    if (tile < 32) { const int base = tile < 28 ? 6144 : 7168, hp = (tile - 24) & 3, hh = (w & 127) >> 6, d = (w & 63) + 64 * (w >> 7); return base + (2 * hp + hh) * 128 + d; }
    return 8192 + 256 * (tile - 32) + w;
}

struct OrderP1 {
    int G, c; const char* xb; const char* win;
    __device__ __forceinline__ bool next(int i, pg8::Unit& u) const {
        const int L = i * G + c; if (L >= 64 * 64) return false;
        pg8::tile_of(L, 64, 64, u.pm, u.pn); u.kind = p1_kind(u.pn);
        const char* xa = xb + (size_t)u.pm * (256 * 2048 * 2); const char* wb = win + (size_t)u.pn * (256 * 2048 * 2);
        const bool sw = (u.kind == KIND_V) || (u.kind == KIND_RV);
        u.a = sw ? wb : xa; u.b = sw ? xa : wb; return true;
    }
};

struct EpiP1 {
    static constexpr bool PERM = true;
    unsigned char* ws; bf16_t* gout; const float* bgate;
    __device__ __forceinline__ void operator()(const f32x4 (&acc)[2][2][4][2], const pg8::Unit& u, int wr, int wc, int fr, int fq) const {
        const int kind = u.kind;
        bf16_t* const uz = (bf16_t*)(ws + WS_UZ); float* const vstat = (float*)(ws + WS_VSTAT); const f32x2* const cs = (const f32x2*)(ws + WS_CS);
        if (kind == KIND_UZ) {
            const int row0 = u.pm * 256 + wr * 64 + fr, col0 = u.pn * 128 + wc * 32 + 8 * fq;
#pragma unroll
            for (int ai = 0; ai < 2; ++ai)
#pragma unroll
                for (int m = 0; m < 4; ++m) {
                    const f32x4 u0 = acc[ai][0][m][0], u1 = acc[ai][0][m][1], z0 = acc[ai][1][m][0], z1 = acc[ai][1][m][1];
                    float r[8];
#pragma unroll
                    for (int j = 0; j < 4; ++j) { r[j] = gelu_silu_f(u0[j], z0[j]); r[4 + j] = gelu_silu_f(u1[j], z1[j]); }
                    u32x4 w; w.x = pk2(r[0], r[1]); w.y = pk2(r[2], r[3]); w.z = pk2(r[4], r[5]); w.w = pk2(r[6], r[7]);
                    *(u32x4*)(uz + (size_t)(row0 + ai * 128 + m * 16) * D + col0) = w;
                }
        } else if (kind == KIND_V || kind == KIND_RV) {
            const int chb = (kind == KIND_V ? (u.pn - 16) : (u.pn - 32)) * 256 + wr * 64 + fr;
            bf16_t* dst = (bf16_t*)(ws + (kind == KIND_V ? WS_VT : WS_RVT));
            const int b = u.pm >> 4, nc0 = (u.pm & 15) * 2, s0 = wc * 32 + 8 * fq;
            float ssum[2][8], ssq[2][8];
#pragma unroll
            for (int bj = 0; bj < 2; ++bj)
#pragma unroll
                for (int j = 0; j < 8; ++j) { ssum[bj][j] = 0.f; ssq[bj][j] = 0.f; }
#pragma unroll
            for (int ai = 0; ai < 2; ++ai)
#pragma unroll
                for (int m = 0; m < 4; ++m) {
                    const int ch = chb + ai * 128 + m * 16;
#pragma unroll
                    for (int bj = 0; bj < 2; ++bj) {
                        float r[8];
#pragma unroll
                        for (int j = 0; j < 4; ++j) { r[j] = acc[ai][bj][m][0][j]; r[4 + j] = acc[ai][bj][m][1][j]; }
                        if (kind == KIND_V) {
#pragma unroll
                            for (int j = 0; j < 8; ++j) { r[j] = gelu_tanh_f(r[j]); ssum[bj][j] += r[j]; ssq[bj][j] += r[j] * r[j]; }
                        }
                        u32x4 w; w.x = pk2(r[0], r[1]); w.y = pk2(r[2], r[3]); w.z = pk2(r[4], r[5]); w.w = pk2(r[6], r[7]);
                        *(u32x4*)(dst + ((size_t)((b * NCH + nc0 + bj) * 2048 + ch)) * CH + s0) = w;
                    }
                }
            if (kind == KIND_V) {
#pragma unroll
                for (int bj = 0; bj < 2; ++bj)
#pragma unroll
                    for (int j = 0; j < 8; ++j) {
                        float a = ssum[bj][j], q2 = ssq[bj][j];
                        a += __shfl_xor(a, 1); a += __shfl_xor(a, 2); a += __shfl_xor(a, 4); a += __shfl_xor(a, 8);
                        q2 += __shfl_xor(q2, 1); q2 += __shfl_xor(q2, 2); q2 += __shfl_xor(q2, 4); q2 += __shfl_xor(q2, 8);
                        if (fr == 0) { float* p = vstat + (size_t)(u.pm * 256 + bj * 128 + s0 + j) * 2; atomicAdd(p, a); atomicAdd(p + 1, q2); }
                    }
            }
        } else if (kind == KIND_Q || kind == KIND_K) {
            const int row0 = u.pm * 256 + wr * 64 + fr;
            const int hp = (u.pn - 24) & 3, head = 2 * hp + (wc >> 1), d0 = (wc & 1) * 32 + 8 * fq;
            bf16_t* dst = (bf16_t*)(ws + (kind == KIND_Q ? WS_Q : WS_K)); const float sc = (kind == KIND_Q) ? 1.0f : K_SCALE;
#pragma unroll
            for (int ai = 0; ai < 2; ++ai)
#pragma unroll
                for (int m = 0; m < 4; ++m) {
                    const int row = row0 + ai * 128 + m * 16, pos = row & (SEQ - 1);
                    const f32x4* cp = (const f32x4*)(cs + (size_t)pos * 64 + d0);
                    const f32x4 c01 = cp[0], c23 = cp[1], c45 = cp[2], c67 = cp[3];
                    const float cs8[8] = {c01[0], c01[2], c23[0], c23[2], c45[0], c45[2], c67[0], c67[2]};
                    const float sn8[8] = {c01[1], c01[3], c23[1], c23[3], c45[1], c45[3], c67[1], c67[3]};
                    float o1[8], o2[8];
#pragma unroll
                    for (int j = 0; j < 8; ++j) {
                        const float x1 = (j < 4) ? acc[ai][0][m][0][j & 3] : acc[ai][0][m][1][j & 3];
                        const float x2 = (j < 4) ? acc[ai][1][m][0][j & 3] : acc[ai][1][m][1][j & 3];
                        o1[j] = (x1 * cs8[j] - x2 * sn8[j]) * sc; o2[j] = (x1 * sn8[j] + x2 * cs8[j]) * sc;
                    }
                    u32x4 w1, w2; w1.x = pk2(o1[0], o1[1]); w1.y = pk2(o1[2], o1[3]); w1.z = pk2(o1[4], o1[5]); w1.w = pk2(o1[6], o1[7]);
                    w2.x = pk2(o2[0], o2[1]); w2.y = pk2(o2[2], o2[3]); w2.z = pk2(o2[4], o2[5]); w2.w = pk2(o2[6], o2[7]);
                    bf16_t* rp = dst + (size_t)row * 1024 + head * 128 + d0;
                    *(u32x4*)rp = w1; *(u32x4*)(rp + 64) = w2;
                    if (kind == KIND_K) {
                        bf16_t* tp = (bf16_t*)(ws + WS_KT) + ((size_t)(row >> 7) * 1024 + head * 128 + d0) * CH + (row & 127);
                        const unsigned a1[4] = {w1.x, w1.y, w1.z, w1.w}, a2[4] = {w2.x, w2.y, w2.z, w2.w};
#pragma unroll
                        for (int j = 0; j < 4; ++j) {
                            tp[(2 * j) * CH] = (bf16_t)(a1[j] & 0xffffu); tp[(2 * j + 1) * CH] = (bf16_t)(a1[j] >> 16);
                            tp[(64 + 2 * j) * CH] = (bf16_t)(a2[j] & 0xffffu); tp[(64 + 2 * j + 1) * CH] = (bf16_t)(a2[j] >> 16);
                        }
                    }
                }
        } else if (kind == KIND_RZ) {
            bf16_t* dst = (bf16_t*)(ws + WS_RZ);
            const int row0 = u.pm * 256 + wr * 64 + fr, col0 = (u.pn - 40) * 256 + wc * 32 + 8 * fq;
#pragma unroll
            for (int ai = 0; ai < 2; ++ai)
#pragma unroll
                for (int m = 0; m < 4; ++m) {
                    bf16_t* rowp = dst + (size_t)(row0 + ai * 128 + m * 16) * D + col0;
#pragma unroll
                    for (int bj = 0; bj < 2; ++bj) {
                        const f32x4 v0 = acc[ai][bj][m][0], v1 = acc[ai][bj][m][1];
                        float r[8];
#pragma unroll
                        for (int j = 0; j < 4; ++j) { r[j] = silu_f(v0[j]); r[4 + j] = silu_f(v1[j]); }
                        u32x4 w; w.x = pk2(r[0], r[1]); w.y = pk2(r[2], r[3]); w.z = pk2(r[4], r[5]); w.w = pk2(r[6], r[7]);
                        *(u32x4*)(rowp + bj * 128) = w;
                    }
                }
        } else {
            const int isb = (kind == KIND_GB) ? 1 : 0;
            bf16_t* dst = gout + (size_t)isb * ((size_t)M * D);
            const int row0 = u.pm * 256 + wr * 64 + fr, col0 = (u.pn - 48 - 8 * isb) * 256 + wc * 32 + 8 * fq;
            const float* bp = bgate + isb * 2048 + col0;
            f32x4 bv[2][2];
#pragma unroll
            for (int bj = 0; bj < 2; ++bj)
#pragma unroll
                for (int n = 0; n < 2; ++n) bv[bj][n] = *(const f32x4*)(bp + bj * 128 + 4 * n);
#pragma unroll
            for (int ai = 0; ai < 2; ++ai)
#pragma unroll
                for (int m = 0; m < 4; ++m) {
                    bf16_t* rowp = dst + (size_t)(row0 + ai * 128 + m * 16) * D + col0;
#pragma unroll
                    for (int bj = 0; bj < 2; ++bj) {
                        const f32x4 v0 = acc[ai][bj][m][0] + bv[bj][0], v1 = acc[ai][bj][m][1] + bv[bj][1];
                        float r[8];
#pragma unroll
                        for (int j = 0; j < 4; ++j) { r[j] = fast_sigmoid(v0[j]); r[4 + j] = fast_sigmoid(v1[j]); }
                        u32x4 w; w.x = pk2(r[0], r[1]); w.y = pk2(r[2], r[3]); w.z = pk2(r[4], r[5]); w.w = pk2(r[6], r[7]);
                        *(u32x4*)(rowp + bj * 128) = w;
                    }
                }
        }
    }
};

struct OrderP3 {
    int G, c; const char *apre, *bpre, *woa, *wob;
    __device__ __forceinline__ bool next(int i, pg8::Unit& u) const {
        const int L = (i >> 1) * G + c; if (L >= 64 * 8) return false;
        pg8::tile_of(L, 64, 8, u.pm, u.pn); u.kind = i & 1;
        u.a = (u.kind ? bpre : apre) + (size_t)u.pm * (256 * 2048 * 2); u.b = (u.kind ? wob : woa) + (size_t)u.pn * (256 * 2048 * 2); return true;
    }
};
struct EpiP3 {
    static constexpr bool PERM = true;
    const bf16_t *ga, *gb; bf16_t* mb;
    __device__ __forceinline__ void operator()(const f32x4 (&acc)[2][2][4][2], const pg8::Unit& u, int wr, int wc, int fr, int fq) const {
        const int row0 = u.pm * 256 + wr * 64 + fr, col0 = u.pn * 256 + wc * 32 + 8 * fq;
        const bf16_t* g = u.kind ? gb : ga;
#pragma unroll
        for (int ai = 0; ai < 2; ++ai)
#pragma unroll
            for (int m = 0; m < 4; ++m) {
                const size_t off = (size_t)(row0 + ai * 128 + m * 16) * D + col0;
#pragma unroll
                for (int bj = 0; bj < 2; ++bj) {
                    const u32x4 gw = *(const u32x4*)(g + off + bj * 128);
                    const f32x4 v0 = acc[ai][bj][m][0], v1 = acc[ai][bj][m][1];
                    float r[8] = {bflo(gw.x) * v0[0], bfhi(gw.x) * v0[1], bflo(gw.y) * v0[2], bfhi(gw.y) * v0[3],
                                  bflo(gw.z) * v1[0], bfhi(gw.z) * v1[1], bflo(gw.w) * v1[2], bfhi(gw.w) * v1[3]};
                    if (u.kind) {
                        const u32x4 pw = *(const u32x4*)(mb + off + bj * 128);
                        r[0] += bflo(pw.x); r[1] += bfhi(pw.x); r[2] += bflo(pw.y); r[3] += bfhi(pw.y);
                        r[4] += bflo(pw.z); r[5] += bfhi(pw.z); r[6] += bflo(pw.w); r[7] += bfhi(pw.w);
                    }
                    u32x4 w; w.x = pk2(r[0], r[1]); w.y = pk2(r[2], r[3]); w.z = pk2(r[4], r[5]); w.w = pk2(r[6], r[7]);
                    *(u32x4*)(mb + off + bj * 128) = w;
                }
            }
    }
};

struct OrderP4 {
    int G, c; const char *mb, *wout;
    __device__ __forceinline__ bool next(int i, pg8::Unit& u) const {
        const int L = i * G + c; if (L >= 64 * 8) return false;
        pg8::tile_of(L, 64, 8, u.pm, u.pn); u.kind = 0;
        u.a = mb + (size_t)u.pm * (256 * 2048 * 2); u.b = wout + (size_t)u.pn * (256 * 2048 * 2); return true;
    }
};
struct EpiP4 {
    static constexpr bool PERM = false;
    const float* x; float* out;
    __device__ __forceinline__ void operator()(const f32x4 (&acc)[2][2][4][2], const pg8::Unit& u, int wr, int wc, int fr, int fq) const {
        const int row0 = u.pm * 256 + wr * 64 + fr, col0 = u.pn * 256 + wc * 32 + 4 * fq;
#pragma unroll
        for (int ai = 0; ai < 2; ++ai)
#pragma unroll
            for (int m = 0; m < 4; ++m) {
                const size_t off = (size_t)(row0 + ai * 128 + m * 16) * D + col0;
#pragma unroll
                for (int bj = 0; bj < 2; ++bj)
#pragma unroll
                    for (int n = 0; n < 2; ++n) {
                        const f32x4 xv = *(const f32x4*)(x + off + bj * 128 + n * 16);
                        *(f32x4*)(out + off + bj * 128 + n * 16) = xv * DN_ALPHA + acc[ai][bj][m][n];
                    }
            }
    }
};


#ifndef MK_XCD_BARRIER
#define MK_XCD_BARRIER 1
#endif
constexpr int CW_BAR = 4096;
constexpr size_t CTL_ZERO_BYTES = 65536;
#define XB_TMO      128
#define XB_XCNT(j)  (256  + 64 * (j))
#define XB_XSUB(j)  (1280 + 64 * (j))
#define XB_XGEN(j)  (2304 + 64 * (j))
#define XB_TOP      3328
#define XB_TOPGEN   3392
#define XCD_BAR_WORDS 3456
#define XB_SPIN_CAP (1u << 18)
__device__ __forceinline__ unsigned xb_ld(unsigned* p)              { return __hip_atomic_load(p, __ATOMIC_RELAXED, __HIP_MEMORY_SCOPE_AGENT); }
__device__ __forceinline__ unsigned xb_add(unsigned* p, unsigned v) { return __hip_atomic_fetch_add(p, v, __ATOMIC_RELAXED, __HIP_MEMORY_SCOPE_AGENT); }
__device__ __forceinline__ unsigned xb_xcc_id() { return (unsigned)__builtin_amdgcn_s_getreg((3 << 11) | 20) & 0xFu; }
#define XB_SPIN(cond, bar) do { unsigned _sp = 0; while (cond) { __builtin_amdgcn_s_sleep(1); \
    if ((++_sp & 255u) == 0u) { if (xb_ld(&(bar)[XB_TMO])) break; if (_sp > XB_SPIN_CAP) { atomicAdd(&(bar)[XB_TMO], 1u); break; } } } } while (0)
struct XcdBarrier { unsigned* bar; unsigned x; volatile LAS unsigned* st; };
__device__ __forceinline__ XcdBarrier xcd_barrier_post(unsigned* bar, volatile LAS unsigned* st) {
    XcdBarrier b; b.bar = bar; b.x = xb_xcc_id(); b.st = st;
    if (threadIdx.x == 0) (void)xb_add(&bar[XB_XCNT(b.x)], 1u);
    return b;
}
__device__ __forceinline__ void xcd_barrier_complete(unsigned* bar, unsigned x, unsigned& nloc, unsigned& nx) {
    const unsigned G = gridDim.x * gridDim.y * gridDim.z;
    unsigned sum, cnt, mine, sp = 0u;
    for (;;) {
        sum = 0u; cnt = 0u; mine = 0u;
#pragma unroll
        for (unsigned j = 0; j < 16; ++j) { const unsigned c = xb_ld(&bar[XB_XCNT(j)]); sum += c; cnt += (c > 0u) ? 1u : 0u; mine = (j == x) ? c : mine; }
        if (sum == G) break;
        __builtin_amdgcn_s_sleep(1);
        if ((++sp & 255u) == 0u) { if (xb_ld(&bar[XB_TMO])) break; if (sp > XB_SPIN_CAP) { atomicAdd(&bar[XB_TMO], 1u); break; } }
    }
    nloc = mine > 0u ? mine : 1u; nx = cnt > 0u ? cnt : 1u;
}
__device__ __forceinline__ void xcd_barrier(const XcdBarrier& b) {
    asm volatile("s_waitcnt vmcnt(0)" ::: "memory");
    __syncthreads();
    if (threadIdx.x == 0) {
        unsigned* bar = b.bar;
        __builtin_amdgcn_s_waitcnt(0);
        unsigned nloc = b.st[0], nx = b.st[1];
        if (nloc == 0u) { xcd_barrier_complete(bar, b.x, nloc, nx); b.st[0] = nloc; b.st[1] = nx; }
        const unsigned old = xb_add(&bar[XB_XSUB(b.x)], 1u);
        const unsigned gen = old / nloc;
        if (old + 1u == (gen + 1u) * nloc) {
            __builtin_amdgcn_fence(__ATOMIC_RELEASE, "agent");
            asm volatile("s_waitcnt vmcnt(0)" ::: "memory");
            const unsigned og = xb_add(&bar[XB_TOP], 1u);
            const unsigned tg = og / nx;
            if (og + 1u == (tg + 1u) * nx) xb_add(&bar[XB_TOPGEN], 1u);
            else XB_SPIN(xb_ld(&bar[XB_TOPGEN]) == tg, bar);
            __builtin_amdgcn_fence(__ATOMIC_ACQUIRE, "agent");
            xb_add(&bar[XB_XGEN(b.x)], 1u);
            asm volatile("s_waitcnt vmcnt(0)" ::: "memory");
        } else {
            XB_SPIN(xb_ld(&bar[XB_XGEN(b.x)]) == gen, bar);
            __builtin_amdgcn_fence(__ATOMIC_ACQUIRE, "agent");
            asm volatile("s_waitcnt vmcnt(0)" ::: "memory");
        }
    }
    __syncthreads();
}

struct Frame {
    LAS unsigned char* lds;
    int tid, lane, wave, vcu, G;
};

__device__ __forceinline__ void p0_transpose_item(const float* W, int N, bf16_t* WT, int row_dst0, int n_src0, int k0, LAS float* scr, int lane) {
    float tv[32];
#pragma unroll
    for (int i = 0; i < 32; ++i) tv[i] = W[(size_t)(k0 + 2 * i + (lane >> 5)) * N + n_src0 + (lane & 31)];
#pragma unroll
    for (int i = 0; i < 32; ++i) scr[(2 * i + (lane >> 5)) * 33 + (lane & 31)] = tv[i];
    LDS_WAIT(); asm volatile("" ::: "memory");
    const int c = lane & 7;
#pragma unroll
    for (int j = 0; j < 4; ++j) { const int n = (lane >> 3) + 8 * j; const LAS float* s = scr + (8 * c) * 33 + n;
        u32x4 o; o.x = pk2(s[0 * 33], s[1 * 33]); o.y = pk2(s[2 * 33], s[3 * 33]); o.z = pk2(s[4 * 33], s[5 * 33]); o.w = pk2(s[6 * 33], s[7 * 33]);
        *(u32x4*)(WT + (size_t)(row_dst0 + n) * 2048 + k0 + 8 * c) = o; }
    LDS_WAIT(); asm volatile("" ::: "memory");
}
__device__ __forceinline__ void sincos_d(float a, float& c, float& s) {
    const double x = (double)a;
    const double kq = __builtin_rint(x * 0.63661977236758134308);
    double y = __builtin_fma(-kq, 1.57079632679489655800e+00, x);
    y = __builtin_fma(-kq, 6.12323399573676603587e-17, y);
    const double y2 = y * y;
    double sp = -7.6471637318198164759e-13;
    sp = sp * y2 + 1.6059043836821614599e-10; sp = sp * y2 - 2.5052108385441718775e-08; sp = sp * y2 + 2.7557319223985890653e-06;
    sp = sp * y2 - 1.9841269841269841270e-04; sp = sp * y2 + 8.3333333333333333333e-03; sp = sp * y2 - 1.6666666666666666667e-01;
    const double sy = y + y * y2 * sp;
    double cp = 4.7794773323873852974e-14;
    cp = cp * y2 - 1.1470745597729724714e-11; cp = cp * y2 + 2.0876756987868098979e-09; cp = cp * y2 - 2.7557319223985890653e-07;
    cp = cp * y2 + 2.4801587301587301587e-05; cp = cp * y2 - 1.3888888888888888889e-03; cp = cp * y2 + 4.1666666666666666667e-02; cp = cp * y2 - 0.5;
    const double cy = 1.0 + y2 * cp;
    const int qd = ((int)kq) & 3;
    const double cc = (qd == 0) ? cy : (qd == 1) ? -sy : (qd == 2) ? -cy : sy;
    const double ss = (qd == 0) ? sy : (qd == 1) ? cy : (qd == 2) ? -sy : -cy;
    c = (float)cc; s = (float)ss;
}

__device__ __forceinline__ void p0_prologue(const Frame& F, const Args& a) {
    unsigned char* ws = a.ws;
    const int gt = F.vcu * 512 + F.tid, NT = F.G * 512;
    const int gw = F.vcu * 8 + F.wave, NGW = F.G * 8;
    { f32x4* p = (f32x4*)(ws + WS_VSTAT); for (int i = gt; i < M * 2 / 4; i += NT) p[i] = (f32x4){0.f, 0.f, 0.f, 0.f}; }
    { f32x2* cs = (f32x2*)(ws + WS_CS);
      for (int i = gt; i < SEQ * 64; i += NT) { const int pos = i >> 6, j = i & 63; const float ang = (float)pos * a.freq[j]; float c, s; sincos_d(ang, c, s); cs[i] = (f32x2){c, s}; } }
    { const float* w_s = a.in[5]; bf16_t* wsm = (bf16_t*)(ws + WS_WSM); float* c2 = (float*)(ws + WS_C2);
      for (int r = gw; r < 8 * 128; r += NGW) { const int t = r & 127; const int s0 = 2 * F.lane;
          const f32x2 v = *(const f32x2*)(w_s + (size_t)r * 128 + s0);
          const unsigned b0 = f2bf((s0 <= t) ? v[0] : 0.f), b1 = f2bf((s0 + 1 <= t) ? v[1] : 0.f);
          *(unsigned*)(wsm + (size_t)r * 128 + s0) = b0 | (b1 << 16);
          const float sum = wave_sum(bf2f((bf16_t)b0) + bf2f((bf16_t)b1));
          if (F.lane == 0) c2[r] = sum; } }
    { const f32x4* x4 = (const f32x4*)a.in[0]; u32x4* xb = (u32x4*)(ws + WS_XB);
      for (int i = gt; i < M * D / 8; i += 4 * NT) { f32x4 v0[4], v1[4];
#pragma unroll
          for (int j = 0; j < 4; ++j) { v0[j] = x4[2 * (i + j * NT)]; v1[j] = x4[2 * (i + j * NT) + 1]; }
#pragma unroll
          for (int j = 0; j < 4; ++j) { u32x4 o; o.x = pk2(v0[j][0], v0[j][1]); o.y = pk2(v0[j][2], v0[j][3]); o.z = pk2(v1[j][0], v1[j][1]); o.w = pk2(v1[j][2], v1[j][3]); xb[i + j * NT] = o; } } }
    { LAS float* scr = (LAS float*)(F.lds + F.wave * 16384);
      constexpr int I_IN = (2048 / 64) * (NIN / 32), I_S = (2048 / 64) * (2048 / 32);
      for (int it = gw; it < I_IN + 3 * I_S; it += NGW) {
          if (it < I_IN) { const int kb = it & 31, rb = it >> 5; p0_transpose_item(a.in[1], NIN, (bf16_t*)(ws + WS_WIN), rb * 32, p1_col(rb * 32), kb * 64, scr, F.lane); }
          else { const int r = it - I_IN, w = r / I_S, q = r % I_S, kb = q & 31, rb = q >> 5;
              const float* W = (w == 0) ? a.in[7] : (w == 1) ? a.in[8] : a.in[9]; bf16_t* WT = (bf16_t*)(ws + (w == 0 ? WS_WOA : w == 1 ? WS_WOB : WS_WOUT));
              p0_transpose_item(W, 2048, WT, rb * 32, rb * 32, kb * 64, scr, F.lane); }
      } }
}

__device__ __forceinline__ void naive_gate_unit(const Frame& F, const Args& a, int unit) {
    unsigned char* ws = a.ws;
    const int g = unit & 7, n = (unit >> 3) & 31, b = unit >> 8;
    const int t0 = b * SEQ + n * CH, c0 = g * 256;
    LAS float* vn = (LAS float*)F.lds;
    LAS float* mu = (LAS float*)(F.lds + 131072);
    LAS float* rs = mu + 128;
    const float* vstat = (const float*)(ws + WS_VSTAT);
    const bf16_t* vT = (const bf16_t*)(ws + WS_VT) + (size_t)((b * NCH + n) * 2048 + c0) * CH;
    const float* lng = a.in[3]; const float* lnb = a.in[4]; const float* w_s = a.in[5]; const float* b_s = a.in[6];
    bf16_t* uz = (bf16_t*)(ws + WS_UZ);
    __syncthreads();
    if (F.tid < 128) { const float s1 = vstat[(size_t)(t0 + F.tid) * 2], s2 = vstat[(size_t)(t0 + F.tid) * 2 + 1]; const float m = s1 * (1.0f / 2048.0f); float var = s2 * (1.0f / 2048.0f) - m * m; var = var > 0.f ? var : 0.f;
        mu[F.tid] = m; rs[F.tid] = 1.0f / sqrtf(var + LN_EPS); }
    __syncthreads();
    for (int i = F.tid; i < 256 * 128; i += 512) { const int c = i >> 7, s = i & 127; const float v = bf2f(vT[i]);
        vn[s * 256 + c] = (v - mu[s]) * rs[s] * lng[c0 + c] + lnb[c0 + c]; }
    __syncthreads();
    const int c = F.tid & 255, th = F.tid >> 8;
    for (int t = th; t < 128; t += 2) {
        const float* wrow = w_s + ((size_t)g * 128 + t) * 128;
        float acc = 0.f;
        for (int s = 0; s <= t; ++s) acc += wrow[s] * vn[s * 256 + c];
        const float sv = acc + b_s[g * 128 + t];
        bf16_t* p = uz + (size_t)(t0 + t) * D + c0 + c;
        *p = (bf16_t)f2bf(bf2f(*p) * sv);
    }
}
__device__ __forceinline__ void naive_kv_unit(const Frame& F, const Args& a, int unit) {
    unsigned char* ws = a.ws;
    const int n = unit & 31, h = (unit >> 5) & 7, b = unit >> 8;
    const int t0 = b * SEQ + n * CH;
    LAS float* kw = (LAS float*)F.lds;
    LAS bf16_t* vs = (LAS bf16_t*)(F.lds + 65536);
    const bf16_t* kg = (const bf16_t*)(ws + WS_K);
    const bf16_t* rvT = (const bf16_t*)(ws + WS_RVT) + (size_t)((b * NCH + n) * 2048 + h * 256) * CH;
    bf16_t* kvT = (bf16_t*)(ws + WS_KVT) + (size_t)((b * 8 + h) * NCH + n) * (256 * 128);
    const float lg = a.lg2[h];
    __syncthreads();
    for (int i = F.tid; i < 128 * 128; i += 512) { const int s = i >> 7, d = i & 127; kw[i] = bf2f(kg[(size_t)(t0 + s) * 1024 + h * 128 + d]) * __builtin_amdgcn_exp2f(lg * (float)(127 - s)); }
    for (int i = F.tid; i < 256 * 128; i += 512) vs[i] = rvT[i];
    __syncthreads();
    const int d = F.tid & 127, eq = F.tid >> 7;
    for (int j0 = 0; j0 < 64; j0 += 8) {
        float acc[8];
#pragma unroll
        for (int j = 0; j < 8; ++j) acc[j] = 0.f;
        for (int s = 0; s < 128; ++s) { const float kv = kw[s * 128 + d];
#pragma unroll
            for (int j = 0; j < 8; ++j) acc[j] += kv * bf2f(vs[(eq * 64 + j0 + j) * 128 + s]); }
#pragma unroll
        for (int j = 0; j < 8; ++j) kvT[(size_t)(eq * 64 + j0 + j) * 128 + d] = (bf16_t)f2bf(acc[j]);
    }
}
__device__ __forceinline__ void scan_phase(const Frame& F, const Args& a) {
    unsigned char* ws = a.ws;
    const int gt = F.vcu * 512 + F.tid, NT = F.G * 512;
    for (int v = gt; v < 32 * 32768 / 8; v += NT) {
        const int bh = v >> 12, off = (v & 4095) * 8;
        const float cd = __builtin_amdgcn_exp2f(a.lg2[bh & 7] * 128.0f);
        const bf16_t* src = (const bf16_t*)(ws + WS_KVT) + (size_t)bh * NCH * 32768 + off;
        bf16_t* dst = (bf16_t*)(ws + WS_RT) + (size_t)bh * NCH * 32768 + off;
        float R[8];
#pragma unroll
        for (int j = 0; j < 8; ++j) R[j] = 0.f;
        for (int n0 = 0; n0 < NCH; n0 += 8) {
            u32x4 kvv[8];
#pragma unroll
            for (int j = 0; j < 8; ++j) kvv[j] = *(const u32x4*)(src + (size_t)(n0 + j) * 32768);
#pragma unroll
            for (int j = 0; j < 8; ++j) { const u32x4 kv = kvv[j];
                u32x4 o; o.x = pk2(R[0], R[1]); o.y = pk2(R[2], R[3]); o.z = pk2(R[4], R[5]); o.w = pk2(R[6], R[7]);
                *(u32x4*)(dst + (size_t)(n0 + j) * 32768) = o;
                R[0] = R[0] * cd + bflo(kv.x); R[1] = R[1] * cd + bfhi(kv.x); R[2] = R[2] * cd + bflo(kv.y); R[3] = R[3] * cd + bfhi(kv.y);
                R[4] = R[4] * cd + bflo(kv.z); R[5] = R[5] * cd + bfhi(kv.z); R[6] = R[6] * cd + bflo(kv.w); R[7] = R[7] * cd + bfhi(kv.w); }
        }
    }
}
__device__ __forceinline__ void naive_ret_unit(const Frame& F, const Args& a, int unit) {
    unsigned char* ws = a.ws;
    const int n = unit & 31, h = (unit >> 5) & 7, b = unit >> 8;
    const int t0 = b * SEQ + n * CH;
    constexpr int RS = 130;
    LAS bf16_t* qs = (LAS bf16_t*)F.lds;
    LAS bf16_t* ks = qs + 128 * RS;
    LAS bf16_t* ps = ks + 128 * RS;
    LAS bf16_t* rs_ = ps + 128 * RS;
    LAS float* st = (LAS float*)(rs_ + 128 * RS);
    const bf16_t* qg = (const bf16_t*)(ws + WS_Q); const bf16_t* kg = (const bf16_t*)(ws + WS_K);
    const bf16_t* rvT = (const bf16_t*)(ws + WS_RVT) + (size_t)((b * NCH + n) * 2048 + h * 256) * CH;
    const bf16_t* RT = (const bf16_t*)(ws + WS_RT) + (size_t)((b * 8 + h) * NCH + n) * (256 * 128);
    bf16_t* rz = (bf16_t*)(ws + WS_RZ);
    float* oscr = (float*)(ws + WS_SCR) + (size_t)blockIdx.x * (128 * 256);
    const float lg = a.lg2[h];
    __syncthreads();
    for (int i = F.tid; i < 128 * 128; i += 512) { const int r = i >> 7, d = i & 127;
        qs[r * RS + d] = qg[(size_t)(t0 + r) * 1024 + h * 128 + d]; ks[r * RS + d] = kg[(size_t)(t0 + r) * 1024 + h * 128 + d]; }
    if (F.tid < 256) st[F.tid] = 0.f;
    __syncthreads();
    { const int t = F.tid >> 2;
      for (int j = 0; j < 32; ++j) { const int s = (F.tid & 3) + 4 * j; float acc = 0.f;
          if (s <= t) { for (int d = 0; d < 128; ++d) acc += bf2f(qs[t * RS + d]) * bf2f(ks[s * RS + d]); acc *= __builtin_amdgcn_exp2f(lg * (float)(t - s)); }
          ps[t * RS + s] = (bf16_t)f2bf(acc); } }
    __syncthreads();
    const int e = F.tid & 127, th = F.tid >> 7;
    for (int eh = 0; eh < 2; ++eh) {
        for (int i = F.tid; i < 128 * 128; i += 512) { const int r = i >> 7, c = i & 127; ks[r * RS + c] = rvT[(size_t)(eh * 128 + r) * 128 + c]; rs_[r * RS + c] = RT[(size_t)(eh * 128 + r) * 128 + c]; }
        __syncthreads();
        for (int t = th; t < 128; t += 4) {
            float inner = 0.f, cross = 0.f;
            for (int s = 0; s <= t; ++s) inner += bf2f(ps[t * RS + s]) * bf2f(ks[e * RS + s]);
            for (int d = 0; d < 128; ++d) cross += bf2f(qs[t * RS + d]) * bf2f(rs_[e * RS + d]);
            const float o = inner + cross * __builtin_amdgcn_exp2f(lg * (float)(t + 1));
            oscr[t * 256 + eh * 128 + e] = o;
            const float s1 = wave_sum(o), s2 = wave_sum(o * o);
            if (F.lane == 0) { atomicAdd((float*)&st[t * 2], s1); atomicAdd((float*)&st[t * 2 + 1], s2); }
        }
        __syncthreads();
    }
    for (int eh = 0; eh < 2; ++eh)
        for (int t = th; t < 128; t += 4) {
            const float mean = st[t * 2] * (1.0f / 256.0f); float var = st[t * 2 + 1] * (1.0f / 256.0f) - mean * mean; var = var > 0.f ? var : 0.f;
            const float rstd = 1.0f / sqrtf(var + LN_EPS);
            const float o = oscr[t * 256 + eh * 128 + e];
            bf16_t* p = rz + (size_t)(t0 + t) * D + h * 256 + eh * 128 + e;
            *p = (bf16_t)f2bf((o - mean) * rstd * bf2f(*p));
        }
}

#define MFMA16(X, Y, C) __builtin_amdgcn_mfma_f32_16x16x32_bf16((X), (Y), (C), 0, 0, 0)
__device__ __forceinline__ bf16x8 ldfrag(const bf16_t* p) { return *(const bf16x8*)p; }
__device__ __forceinline__ bf16x8 pack8(const float (&v)[8]) { u32x4 w; w.x = pk2(v[0], v[1]); w.y = pk2(v[2], v[3]); w.z = pk2(v[4], v[5]); w.w = pk2(v[6], v[7]); return __builtin_bit_cast(bf16x8, w); }
__device__ __forceinline__ void unpack8(bf16x8 f, float (&v)[8]) { const u32x4 w = __builtin_bit_cast(u32x4, f); v[0] = bflo(w.x); v[1] = bfhi(w.x); v[2] = bflo(w.y); v[3] = bfhi(w.y); v[4] = bflo(w.z); v[5] = bfhi(w.z); v[6] = bflo(w.w); v[7] = bfhi(w.w); }

__device__ __forceinline__ void gate_task(const Args& a, int task, int lane) {
    unsigned char* ws = a.ws;
    const int w = task & 7, unit = task >> 3, g = unit & 7, n = (unit >> 3) & 31, b = unit >> 8;
    const int fr = lane & 15, fq = lane >> 4;
    const int t0 = b * SEQ + n * CH, cw = g * 256 + w * 32;
    const bf16_t* vTb = (const bf16_t*)(ws + WS_VT) + ((size_t)(b * NCH + n) * 2048 + cw) * CH;
    const float* vstat = (const float*)(ws + WS_VSTAT) + (size_t)t0 * 2;
    const bf16_t* wsm = (const bf16_t*)(ws + WS_WSM) + (size_t)g * CH * CH;
    const float* c2t = (const float*)(ws + WS_C2) + g * CH; const float* bst = a.in[6] + g * CH;
    bf16_t* uz = (bf16_t*)(ws + WS_UZ);
    bf16x8 xf[2][4];
    const int xrow = 8 * (fr >> 2) + (fr & 3);
#pragma unroll
    for (int kk = 0; kk < 4; ++kk) {
        float mu[8], rs[8];
        const f32x4* sp = (const f32x4*)(vstat + (size_t)(32 * kk + 8 * fq) * 2);
#pragma unroll
        for (int h2 = 0; h2 < 4; ++h2) { const f32x4 v = sp[h2];
            { const float m = v[0] * (1.0f / 2048.0f); float var = v[1] * (1.0f / 2048.0f) - m * m; var = var > 0.f ? var : 0.f; mu[2 * h2] = m; rs[2 * h2] = 1.0f / sqrtf(var + LN_EPS); }
            { const float m = v[2] * (1.0f / 2048.0f); float var = v[3] * (1.0f / 2048.0f) - m * m; var = var > 0.f ? var : 0.f; mu[2 * h2 + 1] = m; rs[2 * h2 + 1] = 1.0f / sqrtf(var + LN_EPS); } }
#pragma unroll
        for (int aa = 0; aa < 2; ++aa) {
            float v[8]; unpack8(ldfrag(vTb + (size_t)(xrow + 4 * aa) * CH + 32 * kk + 8 * fq), v);
#pragma unroll
            for (int q = 0; q < 8; ++q) v[q] = (v[q] - mu[q]) * rs[q];
            xf[aa][kk] = pack8(v);
        }
    }
    float lg8[8], lb8[8];
    { const f32x4* gp = (const f32x4*)(a.in[3] + cw + 8 * fq); const f32x4* bp = (const f32x4*)(a.in[4] + cw + 8 * fq);
      const f32x4 g0 = gp[0], g1 = gp[1], b0 = bp[0], b1 = bp[1];
#pragma unroll
      for (int j = 0; j < 4; ++j) { lg8[j] = g0[j]; lg8[4 + j] = g1[j]; lb8[j] = b0[j]; lb8[4 + j] = b1[j]; } }
#pragma unroll
    for (int tt = 0; tt < 8; ++tt) {
        const int t = 16 * tt + fr;
        f32x4 acc0 = (f32x4){0.f, 0.f, 0.f, 0.f}, acc1 = (f32x4){0.f, 0.f, 0.f, 0.f};
#pragma unroll
        for (int kk = 0; kk < 4; ++kk) if (kk <= (tt >> 1)) {
            const bf16x8 yf = ldfrag(wsm + (size_t)t * CH + 32 * kk + 8 * fq);
            acc0 = MFMA16(xf[0][kk], yf, acc0); acc1 = MFMA16(xf[1][kk], yf, acc1);
        }
        const float c2 = c2t[t], bs = bst[t];
        bf16_t* up = uz + (size_t)(t0 + t) * D + cw + 8 * fq;
        float u8[8]; unpack8(*(const bf16x8*)up, u8);
#pragma unroll
        for (int r = 0; r < 4; ++r) { u8[r] *= lg8[r] * acc0[r] + lb8[r] * c2 + bs; u8[4 + r] *= lg8[4 + r] * acc1[r] + lb8[4 + r] * c2 + bs; }
        *(bf16x8*)up = pack8(u8);
    }
}

__device__ __forceinline__ void kv_task(const Args& a, int task, int lane) {
    unsigned char* ws = a.ws;
    const int w = task & 7, unit = task >> 3, n = unit & 31, h = (unit >> 5) & 7, b = unit >> 8;
    const int fr = lane & 15, fq = lane >> 4;
    const bf16_t* rvTb = (const bf16_t*)(ws + WS_RVT) + ((size_t)(b * NCH + n) * 2048 + h * 256 + 32 * w) * CH;
    const bf16_t* kTb = (const bf16_t*)(ws + WS_KT) + ((size_t)(b * NCH + n) * 1024 + h * 128) * CH;
    bf16_t* kvT = (bf16_t*)(ws + WS_KVT) + (size_t)((b * 8 + h) * NCH + n) * (256 * 128) + (size_t)(32 * w) * 128;
    const float lg = a.lg2[h];
    bf16x8 yf[2][4];
#pragma unroll
    for (int kk = 0; kk < 4; ++kk) {
        float wd[8];
#pragma unroll
        for (int q = 0; q < 8; ++q) wd[q] = __builtin_amdgcn_exp2f(lg * (float)(127 - (32 * kk + 8 * fq + q)));
#pragma unroll
        for (int et = 0; et < 2; ++et) { float v[8]; unpack8(ldfrag(rvTb + (size_t)(16 * et + fr) * CH + 32 * kk + 8 * fq), v);
#pragma unroll
            for (int q = 0; q < 8; ++q) v[q] *= wd[q];
            yf[et][kk] = pack8(v); }
    }
    const int xrow = 8 * (fr >> 2) + (fr & 3);
#pragma unroll
    for (int dp = 0; dp < 4; ++dp) {
        f32x4 acc[2][2];
#pragma unroll
        for (int aa = 0; aa < 2; ++aa)
#pragma unroll
            for (int et = 0; et < 2; ++et) acc[aa][et] = (f32x4){0.f, 0.f, 0.f, 0.f};
#pragma unroll
        for (int kk = 0; kk < 4; ++kk)
#pragma unroll
            for (int aa = 0; aa < 2; ++aa) {
                const bf16x8 xf = ldfrag(kTb + (size_t)(32 * dp + xrow + 4 * aa) * CH + 32 * kk + 8 * fq);
                acc[aa][0] = MFMA16(xf, yf[0][kk], acc[aa][0]); acc[aa][1] = MFMA16(xf, yf[1][kk], acc[aa][1]);
            }
#pragma unroll
        for (int et = 0; et < 2; ++et) {
            const float v[8] = {acc[0][et][0], acc[0][et][1], acc[0][et][2], acc[0][et][3], acc[1][et][0], acc[1][et][1], acc[1][et][2], acc[1][et][3]};
            *(bf16x8*)(kvT + (size_t)(16 * et + fr) * 128 + 32 * dp + 8 * fq) = pack8(v);
        }
    }
}

__device__ __forceinline__ void ret_task(const Args& a, int task, int lane, int wave, LAS unsigned char* lds) {
    unsigned char* ws = a.ws;
    const int w = task & 7, unit = task >> 3, n = unit & 31, h = (unit >> 5) & 7, b = unit >> 8;
    const int fr = lane & 15, fq = lane >> 4;
    const int t0 = b * SEQ + n * CH, tl = 16 * w + fr;
    const bf16_t* qg = (const bf16_t*)(ws + WS_Q) + (size_t)(t0 + tl) * 1024 + h * 128;
    const bf16_t* kg = (const bf16_t*)(ws + WS_K) + (size_t)t0 * 1024 + h * 128;
    const bf16_t* rvTb = (const bf16_t*)(ws + WS_RVT) + ((size_t)(b * NCH + n) * 2048 + h * 256) * CH;
    const bf16_t* RTb = (const bf16_t*)(ws + WS_RT) + (size_t)((b * 8 + h) * NCH + n) * (256 * 128);
    bf16_t* rzp = (bf16_t*)(ws + WS_RZ) + (size_t)(t0 + tl) * D + h * 256;
    const float lg = a.lg2[h];
    const int xrow = 8 * (fr >> 2) + (fr & 3);
    const int nsb = (w >> 1) + 1;
    bf16x8 qf[4];
#pragma unroll
    for (int kk = 0; kk < 4; ++kk) qf[kk] = ldfrag(qg + 32 * kk + 8 * fq);
    bf16x8 pf[4];
#pragma unroll
    for (int sb = 0; sb < 4; ++sb) {
        pf[sb] = (bf16x8){0, 0, 0, 0, 0, 0, 0, 0};
        if (sb < nsb) {
            f32x4 s0 = (f32x4){0.f, 0.f, 0.f, 0.f}, s1 = (f32x4){0.f, 0.f, 0.f, 0.f};
#pragma unroll
            for (int kk = 0; kk < 4; ++kk) {
                const bf16x8 k0 = ldfrag(kg + (size_t)(32 * sb + xrow) * 1024 + 32 * kk + 8 * fq), k1 = ldfrag(kg + (size_t)(32 * sb + xrow + 4) * 1024 + 32 * kk + 8 * fq);
                s0 = MFMA16(k0, qf[kk], s0); s1 = MFMA16(k1, qf[kk], s1);
            }
            float p[8];
#pragma unroll
            for (int r = 0; r < 4; ++r) {
                const int sa = 32 * sb + 8 * fq + r, sbb = sa + 4;
                p[r] = (sa <= tl) ? s0[r] * __builtin_amdgcn_exp2f(lg * (float)(tl - sa)) : 0.f;
                p[4 + r] = (sbb <= tl) ? s1[r] * __builtin_amdgcn_exp2f(lg * (float)(tl - sbb)) : 0.f;
            }
            pf[sb] = pack8(p);
        }
        asm volatile("" ::: "memory");
    }
    const float cdec = __builtin_amdgcn_exp2f(lg * (float)(tl + 1));
    LAS f32x4* ol = (LAS f32x4*)(lds + wave * 16384) + lane;
    float sum = 0.f, sq = 0.f;
#pragma unroll 1
    for (int p = 0; p < 8; ++p) {
        f32x4 ai0 = (f32x4){0.f, 0.f, 0.f, 0.f}, ai1 = ai0, ac0 = ai0, ac1 = ai0;
        const bf16_t* vr = rvTb + (size_t)(32 * p + xrow) * CH + 8 * fq;
        const bf16_t* rr = RTb + (size_t)(32 * p + xrow) * 128 + 8 * fq;
#pragma unroll
        for (int sb = 0; sb < 4; ++sb) if (sb < nsb) {
            ai0 = MFMA16(ldfrag(vr + 32 * sb), pf[sb], ai0); ai1 = MFMA16(ldfrag(vr + 4 * CH + 32 * sb), pf[sb], ai1);
        }
#pragma unroll
        for (int kk = 0; kk < 4; ++kk) {
            ac0 = MFMA16(ldfrag(rr + 32 * kk), qf[kk], ac0); ac1 = MFMA16(ldfrag(rr + 4 * 128 + 32 * kk), qf[kk], ac1);
        }
        const f32x4 o0 = ai0 + ac0 * cdec, o1 = ai1 + ac1 * cdec;
        ol[(2 * p) * 64] = o0; ol[(2 * p + 1) * 64] = o1;
#pragma unroll
        for (int r = 0; r < 4; ++r) { sum += o0[r] + o1[r]; sq += o0[r] * o0[r] + o1[r] * o1[r]; }
    }
    sum += __shfl_xor(sum, 16); sum += __shfl_xor(sum, 32); sq += __shfl_xor(sq, 16); sq += __shfl_xor(sq, 32);
    const float mean = sum * (1.0f / 256.0f); float var = sq * (1.0f / 256.0f) - mean * mean; var = var > 0.f ? var : 0.f;
    const float rstd = 1.0f / sqrtf(var + LN_EPS);
#pragma unroll 1
    for (int p = 0; p < 8; ++p) {
        bf16_t* zp = rzp + 32 * p + 8 * fq;
        const f32x4 o0 = ol[(2 * p) * 64], o1 = ol[(2 * p + 1) * 64];
        float z[8]; unpack8(*(const bf16x8*)zp, z);
#pragma unroll
        for (int r = 0; r < 4; ++r) { z[r] *= (o0[r] - mean) * rstd; z[4 + r] *= (o1[r] - mean) * rstd; }
        *(bf16x8*)zp = pack8(z);
    }
}

__device__ __forceinline__ void ln_phase(const Frame& F, const Args& a) {
    const int gw = F.vcu * 8 + F.wave, NGW = F.G * 8;
    const float* g = a.in[10]; const float* bb = a.in[11];
    for (int m = gw; m < M; m += NGW) {
        f32x4* row = (f32x4*)(a.out + (size_t)m * D) + F.lane;
        f32x4 v[8]; float s = 0.f;
#pragma unroll
        for (int j = 0; j < 8; ++j) { v[j] = row[64 * j]; s += (v[j][0] + v[j][1]) + (v[j][2] + v[j][3]); }
        const float mean = wave_sum(s) * (1.0f / D); float s2 = 0.f;
#pragma unroll
        for (int j = 0; j < 8; ++j) { v[j] = v[j] - mean; s2 += (v[j][0] * v[j][0] + v[j][1] * v[j][1]) + (v[j][2] * v[j][2] + v[j][3] * v[j][3]); }
        const float rstd = 1.0f / sqrtf(wave_sum(s2) * (1.0f / D) + LN_EPS);
#pragma unroll
        for (int j = 0; j < 8; ++j) { const f32x4 gg = *((const f32x4*)g + F.lane + 64 * j), bv = *((const f32x4*)bb + F.lane + 64 * j); row[64 * j] = v[j] * rstd * gg + bv; }
    }
}

__global__ void __launch_bounds__(512, 2) mk_fwd(Args args) {
    extern __shared__ __attribute__((aligned(16))) unsigned char lds_raw[];
    Frame F;
    F.lds = (LAS unsigned char*)lds_raw;
    F.tid = threadIdx.x; F.lane = F.tid & 63; F.wave = __builtin_amdgcn_readfirstlane(F.tid >> 6);
    F.G = gridDim.x; { const int bx = blockIdx.x; F.vcu = (F.G % 8 == 0) ? (bx % 8) * (F.G / 8) + bx / 8 : bx; }
    unsigned char* ws = args.ws;
    const int lo = args.ph_lo, hi = args.ph_hi;
#define IN(k) (lo <= (k) && (k) < hi)
#define BOTH(k) (IN(k) && IN((k) + 1))
#if MK_XCD_BARRIER
    volatile LAS unsigned* MISC = (volatile LAS unsigned*)(F.lds + 131072 + 320);
    if (F.tid < 32) MISC[F.tid] = 0u;
    __syncthreads();
    XcdBarrier xbar; xbar.bar = (unsigned*)(ws + WS_CTL) + CW_BAR; xbar.x = 0; xbar.st = nullptr;
    if (hi - lo > 1) xbar = xcd_barrier_post((unsigned*)(ws + WS_CTL) + CW_BAR, MISC + 8);
#define GRID_BAR() do { xcd_barrier(xbar); } while (0)
#else
#define GRID_BAR() do { cg::this_grid().sync(); } while (0)
#endif

    if (IN(0)) { p0_prologue(F, args); if (BOTH(0)) GRID_BAR(); }
    if (IN(1)) {
        OrderP1 S{F.G, (int)blockIdx.x, (const char*)(ws + WS_XB), (const char*)(ws + WS_WIN)};
        EpiP1 E{ws, (bf16_t*)args.out, args.in[2]};
        pg8::gemm_phase<EpiP1, OrderP1>(F.lds, S, E);
        if (BOTH(1)) GRID_BAR();
    }
    if (IN(2)) {
#if MIX_GATE
        for (int task = F.vcu * 8 + F.wave; task < 8192; task += F.G * 8) gate_task(args, task, F.lane);
#else
        for (int u = F.vcu; u < 1024; u += F.G) naive_gate_unit(F, args, u);
#endif
#if MIX_KV
        for (int task = F.vcu * 8 + F.wave; task < 8192; task += F.G * 8) kv_task(args, task, F.lane);
#else
        for (int u = F.vcu; u < 1024; u += F.G) naive_kv_unit(F, args, u);
#endif
        __syncthreads();
        if (BOTH(2)) GRID_BAR();
    }
    if (IN(3)) { scan_phase(F, args); if (BOTH(3)) GRID_BAR(); }
    if (IN(4)) {
#if MIX_RET
        for (int task = F.vcu * 8 + F.wave; task < 8192; task += F.G * 8) ret_task(args, task, F.lane, F.wave, F.lds);
#else
        for (int u = F.vcu; u < 1024; u += F.G) naive_ret_unit(F, args, u);
#endif
        __syncthreads();
        if (BOTH(4)) GRID_BAR();
    }
    if (IN(5)) {
        OrderP3 S{F.G, (int)blockIdx.x, (const char*)(ws + WS_UZ), (const char*)(ws + WS_RZ), (const char*)(ws + WS_WOA), (const char*)(ws + WS_WOB)};
        EpiP3 E{(const bf16_t*)args.out, (const bf16_t*)args.out + (size_t)M * D, (bf16_t*)(ws + WS_MB)};
        pg8::gemm_phase<EpiP3, OrderP3>(F.lds, S, E);
        if (BOTH(5)) GRID_BAR();
    }
    if (IN(6)) {
        OrderP4 S{F.G, (int)blockIdx.x, (const char*)(ws + WS_MB), (const char*)(ws + WS_WOUT)};
        EpiP4 E{args.in[0], args.out};
        pg8::gemm_phase<EpiP4, OrderP4>(F.lds, S, E);
        if (BOTH(6)) GRID_BAR();
    }
    if (IN(7)) { ln_phase(F, args); }
#undef IN
#undef BOTH
}

extern "C" void kernel_launch(void* const* d_in, const int* in_sizes, int n_in, void* d_out, int out_size, void* d_ws, size_t ws_size, hipStream_t stream) {
    static int grid = 0;
    if (grid == 0) {
        if (n_in != 12 || out_size != M * D || ws_size < WS_END) { fprintf(stderr, "kernel_launch: unexpected shapes (n_in %d, out %d, ws %zu)\n", n_in, out_size, ws_size); grid = -1; return; }
        int dev = 0, cus = 0, per_cu = 0;
        if (hipGetDevice(&dev) != hipSuccess || hipDeviceGetAttribute(&cus, hipDeviceAttributeMultiprocessorCount, dev) != hipSuccess) { grid = -1; return; }
        if (hipFuncSetAttribute((const void*)mk_fwd, hipFuncAttributeMaxDynamicSharedMemorySize, LDS_BYTES) != hipSuccess) { fprintf(stderr, "kernel_launch: hipFuncSetAttribute failed\n"); grid = -1; return; }
        if (hipOccupancyMaxActiveBlocksPerMultiprocessor(&per_cu, (const void*)mk_fwd, 512, LDS_BYTES) != hipSuccess || per_cu < 1) { fprintf(stderr, "kernel_launch: occupancy query says %d blocks per CU\n", per_cu); grid = -1; return; }
        (void)hipGetLastError();
        grid = cus;
    }
    if (grid < 0) return;
    Args a{};
    for (int i = 0; i < 12; ++i) a.in[i] = (const float*)d_in[i];
    a.out = (float*)d_out; a.ws = (unsigned char*)d_ws;
    for (int j = 0; j < 64; ++j) a.freq[j] = (float)std::pow(10000.0, -(double)(2 * j) / 128.0);
    for (int h = 0; h < 8; ++h) a.lg2[h] = (float)(std::log1p(-std::exp2(-5.0 - (double)h)) / std::log(2.0));
#if MK_N_LAUNCHES == 1 && MK_XCD_BARRIER
    a.ph_lo = 0; a.ph_hi = 8;
    if (hipMemsetAsync((char*)d_ws + WS_CTL, 0, CTL_ZERO_BYTES, stream) != hipSuccess) { fprintf(stderr, "kernel_launch: memset failed\n"); return; }
    hipLaunchKernelGGL(mk_fwd, dim3(grid), dim3(512), LDS_BYTES, stream, a);
#elif MK_N_LAUNCHES == 1
    a.ph_lo = 0; a.ph_hi = 8;
    void* kargs[] = {&a};
    hipError_t e = hipLaunchCooperativeKernel((const void*)mk_fwd, dim3(grid), dim3(512), kargs, LDS_BYTES, stream);
    if (e != hipSuccess) fprintf(stderr, "kernel_launch: cooperative launch failed: %s (grid %d)\n", hipGetErrorString(e), grid);
#else
    for (int p = 0; p < 8; ++p) { a.ph_lo = p; a.ph_hi = p + 1; hipLaunchKernelGGL(mk_fwd, dim3(grid), dim3(512), LDS_BYTES, stream, a); }
#endif
}
```

```cpp
#include <hip/hip_runtime.h>
#include <hip/hip_cooperative_groups.h>
#include <cstdio>
#include <cstdint>
#include <cmath>
namespace cg = cooperative_groups;

#ifndef MK_N_LAUNCHES
#define MK_N_LAUNCHES 1
#endif

#ifndef MIX_LDS_GATE
#define MIX_LDS_GATE 1
#endif
#ifndef MIX_LDS_KV
#define MIX_LDS_KV 1
#endif
#ifndef MIX_LDS_RET
#define MIX_LDS_RET 1
#endif
#ifndef MIX_GATE
#define MIX_GATE 1
#endif
#ifndef MIX_KV
#define MIX_KV 1
#endif
#ifndef MIX_RET
#define MIX_RET 1
#endif
#define LAS __attribute__((address_space(3)))
#define GAS __attribute__((address_space(1)))
typedef unsigned short bf16_t;
typedef short bf16x8 __attribute__((ext_vector_type(8)));
typedef float f32x4 __attribute__((ext_vector_type(4)));
typedef float f32x2 __attribute__((ext_vector_type(2)));
typedef unsigned u32x4 __attribute__((ext_vector_type(4)));
typedef unsigned u32x2 __attribute__((ext_vector_type(2)));

constexpr int M = 16384, D = 2048, NIN = 16384, SEQ = 4096, NCH = 32  , CH = 128;
constexpr int NHEAD = 8, DK = 128, DV = 256;
constexpr float LN_EPS = 1e-5f;
constexpr float DN_ALPHA = 1.189207115002721f;
constexpr float K_SCALE = 0.08838834764831845f;

constexpr size_t MiB = 1u << 20;
constexpr size_t WS_CTL = 0;
constexpr size_t WS_WOA = 1 * MiB, WS_WOB = 9 * MiB, WS_WOUT = 17 * MiB;
constexpr size_t WS_CS = 25 * MiB;
constexpr size_t WS_WSM = 27 * MiB;
constexpr size_t WS_C2 = 27 * MiB + 512 * 1024;
constexpr size_t WS_VSTAT = 28 * MiB;
constexpr size_t WS_XB = 32 * MiB, WS_WIN = 96 * MiB;
constexpr size_t WS_UZ = 160 * MiB, WS_VT = 224 * MiB, WS_Q = 288 * MiB, WS_K = 320 * MiB, WS_RVT = 352 * MiB, WS_RZ = 416 * MiB;
constexpr size_t WS_KVT = 32 * MiB, WS_RT = 96 * MiB;
constexpr size_t WS_MB = 224 * MiB;
constexpr size_t WS_SCR = 480 * MiB;
constexpr size_t WS_KT = 480 * MiB;
constexpr size_t WS_END = 512 * MiB;

constexpr int LDS_BYTES = 147456;

__device__ __forceinline__ unsigned f2bf(float f) { unsigned u = __builtin_bit_cast(unsigned, f); return (u + 0x7fffu + ((u >> 16) & 1u)) >> 16; }
typedef __bf16 hwbf16x2 __attribute__((ext_vector_type(2)));
__device__ __forceinline__ unsigned pk2(float lo, float hi) { const f32x2 v = {lo, hi}; const hwbf16x2 b = __builtin_convertvector(v, hwbf16x2); return __builtin_bit_cast(unsigned, b); }
__device__ __forceinline__ float bf2f(unsigned short b) { return __builtin_bit_cast(float, ((unsigned)b) << 16); }
__device__ __forceinline__ float bflo(unsigned w) { return __builtin_bit_cast(float, w << 16); }
__device__ __forceinline__ float bfhi(unsigned w) { return __builtin_bit_cast(float, w & 0xffff0000u); }
__device__ __forceinline__ float fast_sigmoid(float x) { return __builtin_amdgcn_rcpf(1.0f + __builtin_amdgcn_exp2f(-1.4426950408889634f * x)); }
__device__ __forceinline__ float silu_f(float x) { return x * fast_sigmoid(x); }
__device__ __forceinline__ float gelu_tanh_f(float x) {
    return x * __builtin_amdgcn_rcpf(1.0f + __builtin_amdgcn_exp2f(x * (-2.302208198f - 0.10294324f * x * x)));
}
__device__ __forceinline__ float gelu_silu_f(float u, float z) {
    const float e1 = __builtin_amdgcn_exp2f(u * (-2.302208198f - 0.10294324f * u * u)), e2 = __builtin_amdgcn_exp2f(-1.4426950408889634f * z);
    return (u * z) * __builtin_amdgcn_rcpf((1.0f + e1) * (1.0f + e2));
}
__device__ __forceinline__ float wave_sum(float v) {
#pragma unroll
    for (int o = 1; o < 64; o <<= 1) v += __shfl_xor(v, o);
    return v;
}
#define LDS_WAIT() asm volatile("s_waitcnt lgkmcnt(0)" ::: "memory")
#define VM_WAIT() asm volatile("s_waitcnt vmcnt(0)" ::: "memory")

#ifndef PG8_SP2
#define PG8_SP2 1
#endif
namespace pg8 {
constexpr int BM = 256, BK = 64, HALF = 128, HTB = HALF * BK * 2  , STAGE_BYTES = 8 * HTB, NXCD = 8, WGM = 8;
constexpr int KDIM = 2048;

__host__ __device__ __forceinline__ int lds_byte(int r, int c) { const int st = (r >> 4) * 2 + (c >> 5), rr = r & 15, cc = c & 31, ob = rr * 64 + cc * 2; return st * 1024 + (ob ^ (((ob >> 9) & 1) << 5)); }
__host__ __device__ __forceinline__ void stage_rc(int b, int& R, int& C) { const int st = b / 1024, sb = b % 1024, swz = sb ^ (((sb >> 9) & 1) << 5); R = (st >> 1) * 16 + swz / 64; C = (st & 1) * 32 + (swz % 64) / 2; }
__host__ __device__ __forceinline__ int perm32(int rho) { const int n = rho >> 4, i = rho & 15; return 8 * (i >> 2) + 4 * n + (i & 3); }

struct Unit { int pm, pn, kind; const char* a; const char* b; };

__device__ __forceinline__ void tile_of(int L, int nM, int nN, int& pm, int& pn) {
    const int nwg = nM * nN; int wgid = L;
    { const int q = nwg / NXCD, r = nwg % NXCD, xcd = wgid % NXCD, off = wgid / NXCD; wgid = (xcd < r ? xcd * (q + 1) : r * (q + 1) + (xcd - r) * q) + off; }
    const int nig = WGM * nN, gid = wgid / nig, fm = gid * WGM, gsz = (nM - fm) < WGM ? (nM - fm) : WGM;
    pm = fm + ((wgid % nig) % gsz); pn = (wgid % nig) / gsz;
}

template <class Epi, class Sched>
__device__ __forceinline__ void gemm_phase(LAS unsigned char* lds, const Sched& S, const Epi& E) {
    const int tid = threadIdx.x, wid = __builtin_amdgcn_readfirstlane(tid >> 6), lane = tid & 63, wr = wid >> 2, wc = wid & 3, fr = lane & 15, fq = lane >> 4;
    constexpr int K = KDIM, nt = K / BK;
    unsigned voffA[2], voffB[2];
#pragma unroll
    for (int i = 0; i < 2; ++i) { int R, C; stage_rc(tid * 16 + i * 8192, R, C); const int Rb = Epi::PERM ? ((R & ~31) + perm32(R & 31)) : R;
        voffA[i] = (unsigned)(R * K + C) * 2u; voffB[i] = (unsigned)(Rb * K + C) * 2u; }
    constexpr size_t kstep = (size_t)(BK * 2);
    constexpr size_t hstep = (size_t)HALF * K * 2;
    const unsigned ldsw = (unsigned)wid * 1024u;
    const int aoff = lds_byte(wr * 64 + fr, fq * 8), boff = lds_byte(wc * 32 + fr, fq * 8);
#define PG8_SA(b, h) (((b) * 2 + (h)) * HTB)
#define PG8_SB(b, h) ((4 + (b) * 2 + (h)) * HTB)
#define PG8_STAGE(bufoff, gbase, voff) do { _Pragma("unroll") for (int _i = 0; _i < 2; ++_i) \
        __builtin_amdgcn_global_load_lds((const unsigned*)((const char*)(gbase) + (voff)[_i]), (LAS unsigned*)(lds + (bufoff) + ldsw + _i * 8192), 16, 0, 0); } while (0)
#define PG8_LDA(dst, b, h) do { _Pragma("unroll") for (int m = 0; m < 4; ++m) _Pragma("unroll") for (int k = 0; k < 2; ++k) dst[m][k] = *(const LAS bf16x8*)(lds + PG8_SA(b, h) + aoff + m * 2048 + k * 1024); } while (0)
#define PG8_LDB(dst, b, h) do { _Pragma("unroll") for (int n = 0; n < 2; ++n) _Pragma("unroll") for (int k = 0; k < 2; ++k) dst[n][k] = *(const LAS bf16x8*)(lds + PG8_SB(b, h) + boff + n * 2048 + k * 1024); } while (0)
#define PG8_MMA(ai, bj, At, Bt) do { __builtin_amdgcn_s_setprio(1); _Pragma("unroll") for (int m = 0; m < 4; ++m) _Pragma("unroll") for (int n = 0; n < 2; ++n) _Pragma("unroll") for (int k = 0; k < 2; ++k) \
        acc[ai][bj][m][n] = __builtin_amdgcn_mfma_f32_16x16x32_bf16(Bt[n][k], At[m][k], acc[ai][bj][m][n], 0, 0, 0); __builtin_amdgcn_s_setprio(0); } while (0)
#define PG8_WAIT_V(n) asm volatile("s_waitcnt vmcnt(" #n ")" ::: "memory")
#define PG8_WAIT_L(n) asm volatile("s_waitcnt lgkmcnt(" #n ")" ::: "memory")
#define PG8_BAR __builtin_amdgcn_s_barrier()
#define PG8_SCHED __builtin_amdgcn_sched_barrier(0)
    Unit cur, nxt; int ui = 0;
    if (!S.next(0, cur)) return;
    f32x4 acc[2][2][4][2];
#pragma unroll
    for (int a = 0; a < 2; ++a)
#pragma unroll
        for (int b = 0; b < 2; ++b)
#pragma unroll
            for (int m = 0; m < 4; ++m)
#pragma unroll
                for (int n = 0; n < 2; ++n) acc[a][b][m][n] = (f32x4){0.f, 0.f, 0.f, 0.f};
    bf16x8 At[4][2], B0[2][2], B1[2][2];
    const char* cA = cur.a; const char* cB = cur.b;
#if PG8_SP2
    PG8_STAGE(PG8_SB(0, 0), cB, voffB); PG8_STAGE(PG8_SB(0, 1), cB + hstep, voffB); PG8_STAGE(PG8_SA(0, 0), cA, voffA); PG8_STAGE(PG8_SA(0, 1), cA + hstep, voffA);
    if (wr == 1) PG8_BAR;
    PG8_WAIT_V(2); PG8_BAR;
    PG8_STAGE(PG8_SB(1, 0), cB + kstep, voffB); PG8_STAGE(PG8_SA(1, 0), cA + kstep, voffA); PG8_STAGE(PG8_SB(1, 1), cB + hstep + kstep, voffB);
    PG8_WAIT_V(6); PG8_BAR;
#else
    PG8_STAGE(PG8_SB(0, 0), cB, voffB); PG8_STAGE(PG8_SA(0, 0), cA, voffA); PG8_STAGE(PG8_SB(0, 1), cB + hstep, voffB); PG8_STAGE(PG8_SA(0, 1), cA + hstep, voffA);
    if (wr == 1) PG8_BAR;
    PG8_WAIT_V(4); PG8_BAR;
    PG8_STAGE(PG8_SB(1, 0), cB + kstep, voffB); PG8_STAGE(PG8_SA(1, 0), cA + kstep, voffA); PG8_STAGE(PG8_SB(1, 1), cB + hstep + kstep, voffB);
    PG8_WAIT_V(6); PG8_BAR;
#endif
    for (;;) {
        const bool has_next = S.next(ui + 1, nxt);
        const char* nA = has_next ? nxt.a : cA; const char* nB = has_next ? nxt.b : cB;
        for (int t = 0; t < nt; t += 2) {
            const bool last = (t == nt - 2);
            const char* a1 = cA + (size_t)(t + 1) * kstep;
            const char* a2 = last ? nA : cA + (size_t)(t + 2) * kstep; const char* b2 = last ? nB : cB + (size_t)(t + 2) * kstep;
            const char* a3 = a2 + kstep; const char* b3 = b2 + kstep;
#if PG8_SP2
            PG8_LDB(B0, 0, 0); PG8_LDB(B1, 0, 1); PG8_SCHED; PG8_LDA(At, 0, 0); PG8_STAGE(PG8_SA(1, 1), a1 + hstep, voffA);
            PG8_WAIT_V(8); PG8_WAIT_L(0); PG8_BAR; PG8_MMA(0, 0, At, B0); PG8_MMA(0, 1, At, B1); PG8_BAR; PG8_SCHED;
            PG8_LDA(At, 0, 1); PG8_STAGE(PG8_SB(0, 0), b2, voffB); PG8_STAGE(PG8_SB(0, 1), b2 + hstep, voffB); PG8_STAGE(PG8_SA(0, 0), a2, voffA);
            PG8_WAIT_V(8); PG8_WAIT_L(0); PG8_BAR; PG8_MMA(1, 0, At, B0); PG8_MMA(1, 1, At, B1); PG8_BAR; PG8_SCHED;
            PG8_LDB(B0, 1, 0); PG8_LDB(B1, 1, 1); PG8_SCHED; PG8_LDA(At, 1, 0); PG8_STAGE(PG8_SA(0, 1), a2 + hstep, voffA);
            PG8_WAIT_V(8); PG8_WAIT_L(0); PG8_BAR; PG8_MMA(0, 0, At, B0); PG8_MMA(0, 1, At, B1); PG8_BAR; PG8_SCHED;
            PG8_LDA(At, 1, 1); PG8_STAGE(PG8_SB(1, 0), b3, voffB); PG8_STAGE(PG8_SB(1, 1), b3 + hstep, voffB); PG8_STAGE(PG8_SA(1, 0), a3, voffA);
            PG8_WAIT_V(8); PG8_WAIT_L(0); PG8_BAR; PG8_MMA(1, 0, At, B0); PG8_MMA(1, 1, At, B1); PG8_BAR; PG8_SCHED;
        }
#else
            PG8_LDB(B0, 0, 0); PG8_SCHED; PG8_LDA(At, 0, 0); PG8_STAGE(PG8_SA(1, 1), a1 + hstep, voffA);
            PG8_WAIT_L(8); PG8_BAR; PG8_WAIT_L(0); PG8_MMA(0, 0, At, B0); PG8_BAR; PG8_SCHED;
            PG8_LDB(B1, 0, 1); PG8_STAGE(PG8_SB(0, 0), b2, voffB);
            PG8_BAR; PG8_WAIT_L(0); PG8_MMA(0, 1, At, B1); PG8_BAR;
            PG8_LDA(At, 0, 1); PG8_STAGE(PG8_SA(0, 0), a2, voffA);
            PG8_BAR; PG8_WAIT_L(0); PG8_MMA(1, 0, At, B0); PG8_BAR; PG8_SCHED;
            PG8_STAGE(PG8_SB(0, 1), b2 + hstep, voffB);
            PG8_WAIT_V(6); PG8_BAR; PG8_MMA(1, 1, At, B1); PG8_BAR;
            PG8_LDB(B0, 1, 0); PG8_SCHED; PG8_LDA(At, 1, 0); PG8_STAGE(PG8_SA(0, 1), a2 + hstep, voffA);
            PG8_WAIT_L(8); PG8_BAR; PG8_WAIT_L(0); PG8_MMA(0, 0, At, B0); PG8_BAR; PG8_SCHED;
            PG8_LDB(B1, 1, 1); PG8_STAGE(PG8_SB(1, 0), b3, voffB);
            PG8_BAR; PG8_WAIT_L(0); PG8_MMA(0, 1, At, B1); PG8_BAR;
            PG8_LDA(At, 1, 1); PG8_STAGE(PG8_SA(1, 0), a3, voffA);
            PG8_BAR; PG8_WAIT_L(0); PG8_MMA(1, 0, At, B0); PG8_BAR; PG8_SCHED;
            PG8_STAGE(PG8_SB(1, 1), b3 + hstep, voffB);
            PG8_WAIT_V(6); PG8_BAR; PG8_MMA(1, 1, At, B1); PG8_BAR;
        }
#endif
        E(acc, cur, wr, wc, fr, fq);
        if (!has_next) break;
#pragma unroll
        for (int a = 0; a < 2; ++a)
#pragma unroll
            for (int b = 0; b < 2; ++b)
#pragma unroll
                for (int m = 0; m < 4; ++m)
#pragma unroll
                    for (int n = 0; n < 2; ++n) acc[a][b][m][n] = (f32x4){0.f, 0.f, 0.f, 0.f};
        cur = nxt; cA = nA; cB = nB; ++ui;
    }
    PG8_WAIT_V(0);
    if (wr == 0) PG8_BAR;
    PG8_BAR;
#undef PG8_SA
#undef PG8_SB
#undef PG8_STAGE
#undef PG8_LDA
#undef PG8_LDB
#undef PG8_MMA
#undef PG8_WAIT_V
#undef PG8_WAIT_L
#undef PG8_BAR
#undef PG8_SCHED
}
}

struct Args {
    const float* in[12];
    float* out; unsigned char* ws;
    float freq[64];
    float lg2[8];
    int ph_lo, ph_hi;
};

enum { KIND_UZ = 0, KIND_V = 1, KIND_Q = 2, KIND_K = 3, KIND_RV = 4, KIND_RZ = 5, KIND_GA = 6, KIND_GB = 7 };
__host__ __device__ __forceinline__ int p1_kind(int pn) { return pn < 16 ? KIND_UZ : pn < 24 ? KIND_V : pn < 28 ? KIND_Q : pn < 32 ? KIND_K : pn < 40 ? KIND_RV : pn < 48 ? KIND_RZ : pn < 56 ? KIND_GA : KIND_GB; }
__host__ __device__ __forceinline__ int p1_col(int rho) {
    const int tile = rho >> 8, w = rho & 255;
    if (tile < 16) return (w < 128) ? 128 * tile + w : 4096 + 128 * tile + (w - 128);
    if (tile < 24) return 2048 + 256 * (tile - 16) + w;
    if (tile < 32) { const int base = tile < 28 ? 6144 : 7168, hp = (tile - 24) & 3, hh = (w & 127) >> 6, d = (w & 63) + 64 * (w >> 7); return base + (2 * hp + hh) * 128 + d; }
    return 8192 + 256 * (tile - 32) + w;
}

struct OrderP1 {
    int G, c; const char* xb; const char* win;
    __device__ __forceinline__ bool next(int i, pg8::Unit& u) const {
        const int L = i * G + c; if (L >= 64 * 64) return false;
        pg8::tile_of(L, 64, 64, u.pm, u.pn); u.kind = p1_kind(u.pn);
        const char* xa = xb + (size_t)u.pm * (256 * 2048 * 2); const char* wb = win + (size_t)u.pn * (256 * 2048 * 2);
        const bool sw = (u.kind == KIND_V) || (u.kind == KIND_RV);
        u.a = sw ? wb : xa; u.b = sw ? xa : wb; return true;
    }
};

struct EpiP1 {
    static constexpr bool PERM = true;
    unsigned char* ws; bf16_t* gout; const float* bgate;
    __device__ __forceinline__ void operator()(const f32x4 (&acc)[2][2][4][2], const pg8::Unit& u, int wr, int wc, int fr, int fq) const {
        const int kind = u.kind;
        bf16_t* const uz = (bf16_t*)(ws + WS_UZ); float* const vstat = (float*)(ws + WS_VSTAT); const f32x2* const cs = (const f32x2*)(ws + WS_CS);
        if (kind == KIND_UZ) {
            const int row0 = u.pm * 256 + wr * 64 + fr, col0 = u.pn * 128 + wc * 32 + 8 * fq;
#pragma unroll
            for (int ai = 0; ai < 2; ++ai)
#pragma unroll
                for (int m = 0; m < 4; ++m) {
                    const f32x4 u0 = acc[ai][0][m][0], u1 = acc[ai][0][m][1], z0 = acc[ai][1][m][0], z1 = acc[ai][1][m][1];
                    float r[8];
#pragma unroll
                    for (int j = 0; j < 4; ++j) { r[j] = gelu_silu_f(u0[j], z0[j]); r[4 + j] = gelu_silu_f(u1[j], z1[j]); }
                    u32x4 w; w.x = pk2(r[0], r[1]); w.y = pk2(r[2], r[3]); w.z = pk2(r[4], r[5]); w.w = pk2(r[6], r[7]);
                    *(u32x4*)(uz + (size_t)(row0 + ai * 128 + m * 16) * D + col0) = w;
                }
        } else if (kind == KIND_V || kind == KIND_RV) {
            const int chb = (kind == KIND_V ? (u.pn - 16) : (u.pn - 32)) * 256 + wr * 64 + fr;
            bf16_t* dst = (bf16_t*)(ws + (kind == KIND_V ? WS_VT : WS_RVT));
            const int b = u.pm >> 4, nc0 = (u.pm & 15) * 2, s0 = wc * 32 + 8 * fq;
            float ssum[2][8], ssq[2][8];
#pragma unroll
            for (int bj = 0; bj < 2; ++bj)
#pragma unroll
                for (int j = 0; j < 8; ++j) { ssum[bj][j] = 0.f; ssq[bj][j] = 0.f; }
#pragma unroll
            for (int ai = 0; ai < 2; ++ai)
#pragma unroll
                for (int m = 0; m < 4; ++m) {
                    const int ch = chb + ai * 128 + m * 16;
#pragma unroll
                    for (int bj = 0; bj < 2; ++bj) {
                        float r[8];
#pragma unroll
                        for (int j = 0; j < 4; ++j) { r[j] = acc[ai][bj][m][0][j]; r[4 + j] = acc[ai][bj][m][1][j]; }
                        if (kind == KIND_V) {
#pragma unroll
                            for (int j = 0; j < 8; ++j) { r[j] = gelu_tanh_f(r[j]); ssum[bj][j] += r[j]; ssq[bj][j] += r[j] * r[j]; }
                        }
                        u32x4 w; w.x = pk2(r[0], r[1]); w.y = pk2(r[2], r[3]); w.z = pk2(r[4], r[5]); w.w = pk2(r[6], r[7]);
                        *(u32x4*)(dst + ((size_t)((b * NCH + nc0 + bj) * 2048 + ch)) * CH + s0) = w;
                    }
                }
            if (kind == KIND_V) {
#pragma unroll
                for (int bj = 0; bj < 2; ++bj)
#pragma unroll
                    for (int j = 0; j < 8; ++j) {
                        float a = ssum[bj][j], q2 = ssq[bj][j];
                        a += __shfl_xor(a, 1); a += __shfl_xor(a, 2); a += __shfl_xor(a, 4); a += __shfl_xor(a, 8);
                        q2 += __shfl_xor(q2, 1); q2 += __shfl_xor(q2, 2); q2 += __shfl_xor(q2, 4); q2 += __shfl_xor(q2, 8);
                        if (fr == 0) { float* p = vstat + (size_t)(u.pm * 256 + bj * 128 + s0 + j) * 2; atomicAdd(p, a); atomicAdd(p + 1, q2); }
                    }
            }
        } else if (kind == KIND_Q || kind == KIND_K) {
            const int row0 = u.pm * 256 + wr * 64 + fr;
            const int hp = (u.pn - 24) & 3, head = 2 * hp + (wc >> 1), d0 = (wc & 1) * 32 + 8 * fq;
            bf16_t* dst = (bf16_t*)(ws + (kind == KIND_Q ? WS_Q : WS_K)); const float sc = (kind == KIND_Q) ? 1.0f : K_SCALE;
#pragma unroll
            for (int ai = 0; ai < 2; ++ai)
#pragma unroll
                for (int m = 0; m < 4; ++m) {
                    const int row = row0 + ai * 128 + m * 16, pos = row & (SEQ - 1);
                    const f32x4* cp = (const f32x4*)(cs + (size_t)pos * 64 + d0);
                    const f32x4 c01 = cp[0], c23 = cp[1], c45 = cp[2], c67 = cp[3];
                    const float cs8[8] = {c01[0], c01[2], c23[0], c23[2], c45[0], c45[2], c67[0], c67[2]};
                    const float sn8[8] = {c01[1], c01[3], c23[1], c23[3], c45[1], c45[3], c67[1], c67[3]};
                    float o1[8], o2[8];
#pragma unroll
                    for (int j = 0; j < 8; ++j) {
                        const float x1 = (j < 4) ? acc[ai][0][m][0][j & 3] : acc[ai][0][m][1][j & 3];
                        const float x2 = (j < 4) ? acc[ai][1][m][0][j & 3] : acc[ai][1][m][1][j & 3];
                        o1[j] = (x1 * cs8[j] - x2 * sn8[j]) * sc; o2[j] = (x1 * sn8[j] + x2 * cs8[j]) * sc;
                    }
                    u32x4 w1, w2; w1.x = pk2(o1[0], o1[1]); w1.y = pk2(o1[2], o1[3]); w1.z = pk2(o1[4], o1[5]); w1.w = pk2(o1[6], o1[7]);
                    w2.x = pk2(o2[0], o2[1]); w2.y = pk2(o2[2], o2[3]); w2.z = pk2(o2[4], o2[5]); w2.w = pk2(o2[6], o2[7]);
                    bf16_t* rp = dst + (size_t)row * 1024 + head * 128 + d0;
                    *(u32x4*)rp = w1; *(u32x4*)(rp + 64) = w2;
                    if (kind == KIND_K) {
                        bf16_t* tp = (bf16_t*)(ws + WS_KT) + ((size_t)(row >> 7) * 1024 + head * 128 + d0) * CH + (row & 127);
                        const unsigned a1[4] = {w1.x, w1.y, w1.z, w1.w}, a2[4] = {w2.x, w2.y, w2.z, w2.w};
#pragma unroll
                        for (int j = 0; j < 4; ++j) {
                            tp[(2 * j) * CH] = (bf16_t)(a1[j] & 0xffffu); tp[(2 * j + 1) * CH] = (bf16_t)(a1[j] >> 16);
                            tp[(64 + 2 * j) * CH] = (bf16_t)(a2[j] & 0xffffu); tp[(64 + 2 * j + 1) * CH] = (bf16_t)(a2[j] >> 16);
                        }
                    }
                }
        } else if (kind == KIND_RZ) {
            bf16_t* dst = (bf16_t*)(ws + WS_RZ);
            const int row0 = u.pm * 256 + wr * 64 + fr, col0 = (u.pn - 40) * 256 + wc * 32 + 8 * fq;
#pragma unroll
            for (int ai = 0; ai < 2; ++ai)
#pragma unroll
                for (int m = 0; m < 4; ++m) {
                    bf16_t* rowp = dst + (size_t)(row0 + ai * 128 + m * 16) * D + col0;
#pragma unroll
                    for (int bj = 0; bj < 2; ++bj) {
                        const f32x4 v0 = acc[ai][bj][m][0], v1 = acc[ai][bj][m][1];
                        float r[8];
#pragma unroll
                        for (int j = 0; j < 4; ++j) { r[j] = silu_f(v0[j]); r[4 + j] = silu_f(v1[j]); }
                        u32x4 w; w.x = pk2(r[0], r[1]); w.y = pk2(r[2], r[3]); w.z = pk2(r[4], r[5]); w.w = pk2(r[6], r[7]);
                        *(u32x4*)(rowp + bj * 128) = w;
                    }
                }
        } else {
            const int isb = (kind == KIND_GB) ? 1 : 0;
            bf16_t* dst = gout + (size_t)isb * ((size_t)M * D);
            const int row0 = u.pm * 256 + wr * 64 + fr, col0 = (u.pn - 48 - 8 * isb) * 256 + wc * 32 + 8 * fq;
            const float* bp = bgate + isb * 2048 + col0;
            f32x4 bv[2][2];
#pragma unroll
            for (int bj = 0; bj < 2; ++bj)
#pragma unroll
                for (int n = 0; n < 2; ++n) bv[bj][n] = *(const f32x4*)(bp + bj * 128 + 4 * n);
#pragma unroll
            for (int ai = 0; ai < 2; ++ai)
#pragma unroll
                for (int m = 0; m < 4; ++m) {
                    bf16_t* rowp = dst + (size_t)(row0 + ai * 128 + m * 16) * D + col0;
#pragma unroll
                    for (int bj = 0; bj < 2; ++bj) {
                        const f32x4 v0 = acc[ai][bj][m][0] + bv[bj][0], v1 = acc[ai][bj][m][1] + bv[bj][1];
                        float r[8];
#pragma unroll
                        for (int j = 0; j < 4; ++j) { r[j] = fast_sigmoid(v0[j]); r[4 + j] = fast_sigmoid(v1[j]); }
                        u32x4 w; w.x = pk2(r[0], r[1]); w.y = pk2(r[2], r[3]); w.z = pk2(r[4], r[5]); w.w = pk2(r[6], r[7]);
                        *(u32x4*)(rowp + bj * 128) = w;
                    }
                }
        }
    }
};

struct OrderP3 {
    int G, c; const char *apre, *bpre, *woa, *wob;
    __device__ __forceinline__ bool next(int i, pg8::Unit& u) const {
        const int L = (i >> 1) * G + c; if (L >= 64 * 8) return false;
        pg8::tile_of(L, 64, 8, u.pm, u.pn); u.kind = i & 1;
        u.a = (u.kind ? bpre : apre) + (size_t)u.pm * (256 * 2048 * 2); u.b = (u.kind ? wob : woa) + (size_t)u.pn * (256 * 2048 * 2); return true;
    }
};
struct EpiP3 {
    static constexpr bool PERM = true;
    const bf16_t *ga, *gb; bf16_t* mb;
    __device__ __forceinline__ void operator()(const f32x4 (&acc)[2][2][4][2], const pg8::Unit& u, int wr, int wc, int fr, int fq) const {
        const int row0 = u.pm * 256 + wr * 64 + fr, col0 = u.pn * 256 + wc * 32 + 8 * fq;
        const bf16_t* g = u.kind ? gb : ga;
#pragma unroll
        for (int ai = 0; ai < 2; ++ai)
#pragma unroll
            for (int m = 0; m < 4; ++m) {
                const size_t off = (size_t)(row0 + ai * 128 + m * 16) * D + col0;
#pragma unroll
                for (int bj = 0; bj < 2; ++bj) {
                    const u32x4 gw = *(const u32x4*)(g + off + bj * 128);
                    const f32x4 v0 = acc[ai][bj][m][0], v1 = acc[ai][bj][m][1];
                    float r[8] = {bflo(gw.x) * v0[0], bfhi(gw.x) * v0[1], bflo(gw.y) * v0[2], bfhi(gw.y) * v0[3],
                                  bflo(gw.z) * v1[0], bfhi(gw.z) * v1[1], bflo(gw.w) * v1[2], bfhi(gw.w) * v1[3]};
                    if (u.kind) {
                        const u32x4 pw = *(const u32x4*)(mb + off + bj * 128);
                        r[0] += bflo(pw.x); r[1] += bfhi(pw.x); r[2] += bflo(pw.y); r[3] += bfhi(pw.y);
                        r[4] += bflo(pw.z); r[5] += bfhi(pw.z); r[6] += bflo(pw.w); r[7] += bfhi(pw.w);
                    }
                    u32x4 w; w.x = pk2(r[0], r[1]); w.y = pk2(r[2], r[3]); w.z = pk2(r[4], r[5]); w.w = pk2(r[6], r[7]);
                    *(u32x4*)(mb + off + bj * 128) = w;
                }
            }
    }
};

struct OrderP4 {
    int G, c; const char *mb, *wout;
    __device__ __forceinline__ bool next(int i, pg8::Unit& u) const {
        const int L = i * G + c; if (L >= 64 * 8) return false;
        pg8::tile_of(L, 64, 8, u.pm, u.pn); u.kind = 0;
        u.a = mb + (size_t)u.pm * (256 * 2048 * 2); u.b = wout + (size_t)u.pn * (256 * 2048 * 2); return true;
    }
};
struct EpiP4 {
    static constexpr bool PERM = false;
    const float* x; float* out;
    __device__ __forceinline__ void operator()(const f32x4 (&acc)[2][2][4][2], const pg8::Unit& u, int wr, int wc, int fr, int fq) const {
        const int row0 = u.pm * 256 + wr * 64 + fr, col0 = u.pn * 256 + wc * 32 + 4 * fq;
#pragma unroll
        for (int ai = 0; ai < 2; ++ai)
#pragma unroll
            for (int m = 0; m < 4; ++m) {
                const size_t off = (size_t)(row0 + ai * 128 + m * 16) * D + col0;
#pragma unroll
                for (int bj = 0; bj < 2; ++bj)
#pragma unroll
                    for (int n = 0; n < 2; ++n) {
                        const f32x4 xv = *(const f32x4*)(x + off + bj * 128 + n * 16);
                        *(f32x4*)(out + off + bj * 128 + n * 16) = xv * DN_ALPHA + acc[ai][bj][m][n];
                    }
            }
    }
};


#ifndef MK_XCD_BARRIER
#define MK_XCD_BARRIER 1
#endif
constexpr int CW_BAR = 4096;
constexpr size_t CTL_ZERO_BYTES = 65536;
#define XB_TMO      128
#define XB_XCNT(j)  (256  + 64 * (j))
#define XB_XSUB(j)  (1280 + 64 * (j))
#define XB_XGEN(j)  (2304 + 64 * (j))
#define XB_TOP      3328
#define XB_TOPGEN   3392
#define XCD_BAR_WORDS 3456
#define XB_SPIN_CAP (1u << 18)
__device__ __forceinline__ unsigned xb_ld(unsigned* p)              { return __hip_atomic_load(p, __ATOMIC_RELAXED, __HIP_MEMORY_SCOPE_AGENT); }
__device__ __forceinline__ unsigned xb_add(unsigned* p, unsigned v) { return __hip_atomic_fetch_add(p, v, __ATOMIC_RELAXED, __HIP_MEMORY_SCOPE_AGENT); }
__device__ __forceinline__ unsigned xb_xcc_id() { return (unsigned)__builtin_amdgcn_s_getreg((3 << 11) | 20) & 0xFu; }
#define XB_SPIN(cond, bar) do { unsigned _sp = 0; while (cond) { __builtin_amdgcn_s_sleep(1); \
    if ((++_sp & 255u) == 0u) { if (xb_ld(&(bar)[XB_TMO])) break; if (_sp > XB_SPIN_CAP) { atomicAdd(&(bar)[XB_TMO], 1u); break; } } } } while (0)
struct XcdBarrier { unsigned* bar; unsigned x; volatile LAS unsigned* st; };
__device__ __forceinline__ XcdBarrier xcd_barrier_post(unsigned* bar, volatile LAS unsigned* st) {
    XcdBarrier b; b.bar = bar; b.x = xb_xcc_id(); b.st = st;
    if (threadIdx.x == 0) (void)xb_add(&bar[XB_XCNT(b.x)], 1u);
    return b;
}
__device__ __forceinline__ void xcd_barrier_complete(unsigned* bar, unsigned x, unsigned& nloc, unsigned& nx) {
    const unsigned G = gridDim.x * gridDim.y * gridDim.z;
    unsigned sum, cnt, mine, sp = 0u;
    for (;;) {
        sum = 0u; cnt = 0u; mine = 0u;
#pragma unroll
        for (unsigned j = 0; j < 16; ++j) { const unsigned c = xb_ld(&bar[XB_XCNT(j)]); sum += c; cnt += (c > 0u) ? 1u : 0u; mine = (j == x) ? c : mine; }
        if (sum == G) break;
        __builtin_amdgcn_s_sleep(1);
        if ((++sp & 255u) == 0u) { if (xb_ld(&bar[XB_TMO])) break; if (sp > XB_SPIN_CAP) { atomicAdd(&bar[XB_TMO], 1u); break; } }
    }
    nloc = mine > 0u ? mine : 1u; nx = cnt > 0u ? cnt : 1u;
}
__device__ __forceinline__ void xcd_barrier(const XcdBarrier& b) {
    asm volatile("s_waitcnt vmcnt(0)" ::: "memory");
    __syncthreads();
    if (threadIdx.x == 0) {
        unsigned* bar = b.bar;
        __builtin_amdgcn_s_waitcnt(0);
        unsigned nloc = b.st[0], nx = b.st[1];
        if (nloc == 0u) { xcd_barrier_complete(bar, b.x, nloc, nx); b.st[0] = nloc; b.st[1] = nx; }
        const unsigned old = xb_add(&bar[XB_XSUB(b.x)], 1u);
        const unsigned gen = old / nloc;
        if (old + 1u == (gen + 1u) * nloc) {
            __builtin_amdgcn_fence(__ATOMIC_RELEASE, "agent");
            asm volatile("s_waitcnt vmcnt(0)" ::: "memory");
            const unsigned og = xb_add(&bar[XB_TOP], 1u);
            const unsigned tg = og / nx;
            if (og + 1u == (tg + 1u) * nx) xb_add(&bar[XB_TOPGEN], 1u);
            else XB_SPIN(xb_ld(&bar[XB_TOPGEN]) == tg, bar);
            __builtin_amdgcn_fence(__ATOMIC_ACQUIRE, "agent");
            xb_add(&bar[XB_XGEN(b.x)], 1u);
            asm volatile("s_waitcnt vmcnt(0)" ::: "memory");
        } else {
            XB_SPIN(xb_ld(&bar[XB_XGEN(b.x)]) == gen, bar);
            __builtin_amdgcn_fence(__ATOMIC_ACQUIRE, "agent");
            asm volatile("s_waitcnt vmcnt(0)" ::: "memory");
        }
    }
    __syncthreads();
}

struct Frame {
    LAS unsigned char* lds;
    int tid, lane, wave, vcu, G;
};

__device__ __forceinline__ void p0_transpose_item(const float* W, int N, bf16_t* WT, int row_dst0, int n_src0, int k0, LAS float* scr, int lane) {
    float tv[32];
#pragma unroll
    for (int i = 0; i < 32; ++i) tv[i] = W[(size_t)(k0 + 2 * i + (lane >> 5)) * N + n_src0 + (lane & 31)];
#pragma unroll
    for (int i = 0; i < 32; ++i) scr[(2 * i + (lane >> 5)) * 33 + (lane & 31)] = tv[i];
    LDS_WAIT(); asm volatile("" ::: "memory");
    const int c = lane & 7;
#pragma unroll
    for (int j = 0; j < 4; ++j) { const int n = (lane >> 3) + 8 * j; const LAS float* s = scr + (8 * c) * 33 + n;
        u32x4 o; o.x = pk2(s[0 * 33], s[1 * 33]); o.y = pk2(s[2 * 33], s[3 * 33]); o.z = pk2(s[4 * 33], s[5 * 33]); o.w = pk2(s[6 * 33], s[7 * 33]);
        *(u32x4*)(WT + (size_t)(row_dst0 + n) * 2048 + k0 + 8 * c) = o; }
    LDS_WAIT(); asm volatile("" ::: "memory");
}
__device__ __forceinline__ void sincos_d(float a, float& c, float& s) {
    const double x = (double)a;
    const double kq = __builtin_rint(x * 0.63661977236758134308);
    double y = __builtin_fma(-kq, 1.57079632679489655800e+00, x);
    y = __builtin_fma(-kq, 6.12323399573676603587e-17, y);
    const double y2 = y * y;
    double sp = -7.6471637318198164759e-13;
    sp = sp * y2 + 1.6059043836821614599e-10; sp = sp * y2 - 2.5052108385441718775e-08; sp = sp * y2 + 2.7557319223985890653e-06;
    sp = sp * y2 - 1.9841269841269841270e-04; sp = sp * y2 + 8.3333333333333333333e-03; sp = sp * y2 - 1.6666666666666666667e-01;
    const double sy = y + y * y2 * sp;
    double cp = 4.7794773323873852974e-14;
    cp = cp * y2 - 1.1470745597729724714e-11; cp = cp * y2 + 2.0876756987868098979e-09; cp = cp * y2 - 2.7557319223985890653e-07;
    cp = cp * y2 + 2.4801587301587301587e-05; cp = cp * y2 - 1.3888888888888888889e-03; cp = cp * y2 + 4.1666666666666666667e-02; cp = cp * y2 - 0.5;
    const double cy = 1.0 + y2 * cp;
    const int qd = ((int)kq) & 3;
    const double cc = (qd == 0) ? cy : (qd == 1) ? -sy : (qd == 2) ? -cy : sy;
    const double ss = (qd == 0) ? sy : (qd == 1) ? cy : (qd == 2) ? -sy : -cy;
    c = (float)cc; s = (float)ss;
}

__device__ __forceinline__ void p0_prologue(const Frame& F, const Args& a) {
    unsigned char* ws = a.ws;
    const int gt = F.vcu * 512 + F.tid, NT = F.G * 512;
    const int gw = F.vcu * 8 + F.wave, NGW = F.G * 8;
    { f32x4* p = (f32x4*)(ws + WS_VSTAT); for (int i = gt; i < M * 2 / 4; i += NT) p[i] = (f32x4){0.f, 0.f, 0.f, 0.f}; }
    { f32x2* cs = (f32x2*)(ws + WS_CS);
      for (int i = gt; i < SEQ * 64; i += NT) { const int pos = i >> 6, j = i & 63; const float ang = (float)pos * a.freq[j]; float c, s; sincos_d(ang, c, s); cs[i] = (f32x2){c, s}; } }
    { const float* w_s = a.in[5]; bf16_t* wsm = (bf16_t*)(ws + WS_WSM); float* c2 = (float*)(ws + WS_C2);
      for (int r = gw; r < 8 * 128; r += NGW) { const int t = r & 127; const int s0 = 2 * F.lane;
          const f32x2 v = *(const f32x2*)(w_s + (size_t)r * 128 + s0);
          const unsigned b0 = f2bf((s0 <= t) ? v[0] : 0.f), b1 = f2bf((s0 + 1 <= t) ? v[1] : 0.f);
          *(unsigned*)(wsm + (size_t)r * 128 + s0) = b0 | (b1 << 16);
          const float sum = wave_sum(bf2f((bf16_t)b0) + bf2f((bf16_t)b1));
          if (F.lane == 0) c2[r] = sum; } }
    { const f32x4* x4 = (const f32x4*)a.in[0]; u32x4* xb = (u32x4*)(ws + WS_XB);
      for (int i = gt; i < M * D / 8; i += 4 * NT) { f32x4 v0[4], v1[4];
#pragma unroll
          for (int j = 0; j < 4; ++j) { v0[j] = x4[2 * (i + j * NT)]; v1[j] = x4[2 * (i + j * NT) + 1]; }
#pragma unroll
          for (int j = 0; j < 4; ++j) { u32x4 o; o.x = pk2(v0[j][0], v0[j][1]); o.y = pk2(v0[j][2], v0[j][3]); o.z = pk2(v1[j][0], v1[j][1]); o.w = pk2(v1[j][2], v1[j][3]); xb[i + j * NT] = o; } } }
    { LAS float* scr = (LAS float*)(F.lds + F.wave * 16384);
      constexpr int I_IN = (2048 / 64) * (NIN / 32), I_S = (2048 / 64) * (2048 / 32);
      for (int it = gw; it < I_IN + 3 * I_S; it += NGW) {
          if (it < I_IN) { const int kb = it & 31, rb = it >> 5; p0_transpose_item(a.in[1], NIN, (bf16_t*)(ws + WS_WIN), rb * 32, p1_col(rb * 32), kb * 64, scr, F.lane); }
          else { const int r = it - I_IN, w = r / I_S, q = r % I_S, kb = q & 31, rb = q >> 5;
              const float* W = (w == 0) ? a.in[7] : (w == 1) ? a.in[8] : a.in[9]; bf16_t* WT = (bf16_t*)(ws + (w == 0 ? WS_WOA : w == 1 ? WS_WOB : WS_WOUT));
              p0_transpose_item(W, 2048, WT, rb * 32, rb * 32, kb * 64, scr, F.lane); }
      } }
}

__device__ __forceinline__ void naive_gate_unit(const Frame& F, const Args& a, int unit) {
    unsigned char* ws = a.ws;
    const int g = unit & 7, n = (unit >> 3) & 31, b = unit >> 8;
    const int t0 = b * SEQ + n * CH, c0 = g * 256;
    LAS float* vn = (LAS float*)F.lds;
    LAS float* mu = (LAS float*)(F.lds + 131072);
    LAS float* rs = mu + 128;
    const float* vstat = (const float*)(ws + WS_VSTAT);
    const bf16_t* vT = (const bf16_t*)(ws + WS_VT) + (size_t)((b * NCH + n) * 2048 + c0) * CH;
    const float* lng = a.in[3]; const float* lnb = a.in[4]; const float* w_s = a.in[5]; const float* b_s = a.in[6];
    bf16_t* uz = (bf16_t*)(ws + WS_UZ);
    __syncthreads();
    if (F.tid < 128) { const float s1 = vstat[(size_t)(t0 + F.tid) * 2], s2 = vstat[(size_t)(t0 + F.tid) * 2 + 1]; const float m = s1 * (1.0f / 2048.0f); float var = s2 * (1.0f / 2048.0f) - m * m; var = var > 0.f ? var : 0.f;
        mu[F.tid] = m; rs[F.tid] = 1.0f / sqrtf(var + LN_EPS); }
    __syncthreads();
    for (int i = F.tid; i < 256 * 128; i += 512) { const int c = i >> 7, s = i & 127; const float v = bf2f(vT[i]);
        vn[s * 256 + c] = (v - mu[s]) * rs[s] * lng[c0 + c] + lnb[c0 + c]; }
    __syncthreads();
    const int c = F.tid & 255, th = F.tid >> 8;
    for (int t = th; t < 128; t += 2) {
        const float* wrow = w_s + ((size_t)g * 128 + t) * 128;
        float acc = 0.f;
        for (int s = 0; s <= t; ++s) acc += wrow[s] * vn[s * 256 + c];
        const float sv = acc + b_s[g * 128 + t];
        bf16_t* p = uz + (size_t)(t0 + t) * D + c0 + c;
        *p = (bf16_t)f2bf(bf2f(*p) * sv);
    }
}
__device__ __forceinline__ void naive_kv_unit(const Frame& F, const Args& a, int unit) {
    unsigned char* ws = a.ws;
    const int n = unit & 31, h = (unit >> 5) & 7, b = unit >> 8;
    const int t0 = b * SEQ + n * CH;
    LAS float* kw = (LAS float*)F.lds;
    LAS bf16_t* vs = (LAS bf16_t*)(F.lds + 65536);
    const bf16_t* kg = (const bf16_t*)(ws + WS_K);
    const bf16_t* rvT = (const bf16_t*)(ws + WS_RVT) + (size_t)((b * NCH + n) * 2048 + h * 256) * CH;
    bf16_t* kvT = (bf16_t*)(ws + WS_KVT) + (size_t)((b * 8 + h) * NCH + n) * (256 * 128);
    const float lg = a.lg2[h];
    __syncthreads();
    for (int i = F.tid; i < 128 * 128; i += 512) { const int s = i >> 7, d = i & 127; kw[i] = bf2f(kg[(size_t)(t0 + s) * 1024 + h * 128 + d]) * __builtin_amdgcn_exp2f(lg * (float)(127 - s)); }
    for (int i = F.tid; i < 256 * 128; i += 512) vs[i] = rvT[i];
    __syncthreads();
    const int d = F.tid & 127, eq = F.tid >> 7;
    for (int j0 = 0; j0 < 64; j0 += 8) {
        float acc[8];
#pragma unroll
        for (int j = 0; j < 8; ++j) acc[j] = 0.f;
        for (int s = 0; s < 128; ++s) { const float kv = kw[s * 128 + d];
#pragma unroll
            for (int j = 0; j < 8; ++j) acc[j] += kv * bf2f(vs[(eq * 64 + j0 + j) * 128 + s]); }
#pragma unroll
        for (int j = 0; j < 8; ++j) kvT[(size_t)(eq * 64 + j0 + j) * 128 + d] = (bf16_t)f2bf(acc[j]);
    }
}
__device__ __forceinline__ void scan_phase(const Frame& F, const Args& a) {
    unsigned char* ws = a.ws;
    const int gt = F.vcu * 512 + F.tid, NT = F.G * 512;
    for (int v = gt; v < 32 * 32768 / 8; v += NT) {
        const int bh = v >> 12, off = (v & 4095) * 8;
        const float cd = __builtin_amdgcn_exp2f(a.lg2[bh & 7] * 128.0f);
        const bf16_t* src = (const bf16_t*)(ws + WS_KVT) + (size_t)bh * NCH * 32768 + off;
        bf16_t* dst = (bf16_t*)(ws + WS_RT) + (size_t)bh * NCH * 32768 + off;
        float R[8];
#pragma unroll
        for (int j = 0; j < 8; ++j) R[j] = 0.f;
        for (int n0 = 0; n0 < NCH; n0 += 8) {
            u32x4 kvv[8];
#pragma unroll
            for (int j = 0; j < 8; ++j) kvv[j] = *(const u32x4*)(src + (size_t)(n0 + j) * 32768);
#pragma unroll
            for (int j = 0; j < 8; ++j) { const u32x4 kv = kvv[j];
                u32x4 o; o.x = pk2(R[0], R[1]); o.y = pk2(R[2], R[3]); o.z = pk2(R[4], R[5]); o.w = pk2(R[6], R[7]);
                *(u32x4*)(dst + (size_t)(n0 + j) * 32768) = o;
                R[0] = R[0] * cd + bflo(kv.x); R[1] = R[1] * cd + bfhi(kv.x); R[2] = R[2] * cd + bflo(kv.y); R[3] = R[3] * cd + bfhi(kv.y);
                R[4] = R[4] * cd + bflo(kv.z); R[5] = R[5] * cd + bfhi(kv.z); R[6] = R[6] * cd + bflo(kv.w); R[7] = R[7] * cd + bfhi(kv.w); }
        }
    }
}
__device__ __forceinline__ void naive_ret_unit(const Frame& F, const Args& a, int unit) {
    unsigned char* ws = a.ws;
    const int n = unit & 31, h = (unit >> 5) & 7, b = unit >> 8;
    const int t0 = b * SEQ + n * CH;
    constexpr int RS = 130;
    LAS bf16_t* qs = (LAS bf16_t*)F.lds;
    LAS bf16_t* ks = qs + 128 * RS;
    LAS bf16_t* ps = ks + 128 * RS;
    LAS bf16_t* rs_ = ps + 128 * RS;
    LAS float* st = (LAS float*)(rs_ + 128 * RS);
    const bf16_t* qg = (const bf16_t*)(ws + WS_Q); const bf16_t* kg = (const bf16_t*)(ws + WS_K);
    const bf16_t* rvT = (const bf16_t*)(ws + WS_RVT) + (size_t)((b * NCH + n) * 2048 + h * 256) * CH;
    const bf16_t* RT = (const bf16_t*)(ws + WS_RT) + (size_t)((b * 8 + h) * NCH + n) * (256 * 128);
    bf16_t* rz = (bf16_t*)(ws + WS_RZ);
    float* oscr = (float*)(ws + WS_SCR) + (size_t)blockIdx.x * (128 * 256);
    const float lg = a.lg2[h];
    __syncthreads();
    for (int i = F.tid; i < 128 * 128; i += 512) { const int r = i >> 7, d = i & 127;
        qs[r * RS + d] = qg[(size_t)(t0 + r) * 1024 + h * 128 + d]; ks[r * RS + d] = kg[(size_t)(t0 + r) * 1024 + h * 128 + d]; }
    if (F.tid < 256) st[F.tid] = 0.f;
    __syncthreads();
    { const int t = F.tid >> 2;
      for (int j = 0; j < 32; ++j) { const int s = (F.tid & 3) + 4 * j; float acc = 0.f;
          if (s <= t) { for (int d = 0; d < 128; ++d) acc += bf2f(qs[t * RS + d]) * bf2f(ks[s * RS + d]); acc *= __builtin_amdgcn_exp2f(lg * (float)(t - s)); }
          ps[t * RS + s] = (bf16_t)f2bf(acc); } }
    __syncthreads();
    const int e = F.tid & 127, th = F.tid >> 7;
    for (int eh = 0; eh < 2; ++eh) {
        for (int i = F.tid; i < 128 * 128; i += 512) { const int r = i >> 7, c = i & 127; ks[r * RS + c] = rvT[(size_t)(eh * 128 + r) * 128 + c]; rs_[r * RS + c] = RT[(size_t)(eh * 128 + r) * 128 + c]; }
        __syncthreads();
        for (int t = th; t < 128; t += 4) {
            float inner = 0.f, cross = 0.f;
            for (int s = 0; s <= t; ++s) inner += bf2f(ps[t * RS + s]) * bf2f(ks[e * RS + s]);
            for (int d = 0; d < 128; ++d) cross += bf2f(qs[t * RS + d]) * bf2f(rs_[e * RS + d]);
            const float o = inner + cross * __builtin_amdgcn_exp2f(lg * (float)(t + 1));
            oscr[t * 256 + eh * 128 + e] = o;
            const float s1 = wave_sum(o), s2 = wave_sum(o * o);
            if (F.lane == 0) { atomicAdd((float*)&st[t * 2], s1); atomicAdd((float*)&st[t * 2 + 1], s2); }
        }
        __syncthreads();
    }
    for (int eh = 0; eh < 2; ++eh)
        for (int t = th; t < 128; t += 4) {
            const float mean = st[t * 2] * (1.0f / 256.0f); float var = st[t * 2 + 1] * (1.0f / 256.0f) - mean * mean; var = var > 0.f ? var : 0.f;
            const float rstd = 1.0f / sqrtf(var + LN_EPS);
            const float o = oscr[t * 256 + eh * 128 + e];
            bf16_t* p = rz + (size_t)(t0 + t) * D + h * 256 + eh * 128 + e;
            *p = (bf16_t)f2bf((o - mean) * rstd * bf2f(*p));
        }
}

#define MFMA16(X, Y, C) __builtin_amdgcn_mfma_f32_16x16x32_bf16((X), (Y), (C), 0, 0, 0)
__device__ __forceinline__ bf16x8 ldfrag(const bf16_t* p) { return *(const bf16x8*)p; }
__device__ __forceinline__ bf16x8 pack8(const float (&v)[8]) { u32x4 w; w.x = pk2(v[0], v[1]); w.y = pk2(v[2], v[3]); w.z = pk2(v[4], v[5]); w.w = pk2(v[6], v[7]); return __builtin_bit_cast(bf16x8, w); }
__device__ __forceinline__ void unpack8(bf16x8 f, float (&v)[8]) { const u32x4 w = __builtin_bit_cast(u32x4, f); v[0] = bflo(w.x); v[1] = bfhi(w.x); v[2] = bflo(w.y); v[3] = bfhi(w.y); v[4] = bflo(w.z); v[5] = bfhi(w.z); v[6] = bflo(w.w); v[7] = bfhi(w.w); }

__device__ __forceinline__ void gate_task(const Args& a, int task, int lane) {
    unsigned char* ws = a.ws;
    const int w = task & 7, unit = task >> 3, g = unit & 7, n = (unit >> 3) & 31, b = unit >> 8;
    const int fr = lane & 15, fq = lane >> 4;
    const int t0 = b * SEQ + n * CH, cw = g * 256 + w * 32;
    const bf16_t* vTb = (const bf16_t*)(ws + WS_VT) + ((size_t)(b * NCH + n) * 2048 + cw) * CH;
    const float* vstat = (const float*)(ws + WS_VSTAT) + (size_t)t0 * 2;
    const bf16_t* wsm = (const bf16_t*)(ws + WS_WSM) + (size_t)g * CH * CH;
    const float* c2t = (const float*)(ws + WS_C2) + g * CH; const float* bst = a.in[6] + g * CH;
    bf16_t* uz = (bf16_t*)(ws + WS_UZ) + (size_t)t0 * D + cw + 8 * fq;
    const int xrow = 8 * (fr >> 2) + (fr & 3);
    bf16x8 xraw[2][4]; f32x4 st4[4][4]; bf16x8 u8v[8]; float c2v[8], bsv[8]; bf16x8 yf[20];
#pragma unroll
    for (int kk = 0; kk < 4; ++kk) {
#pragma unroll
        for (int aa = 0; aa < 2; ++aa) xraw[aa][kk] = ldfrag(vTb + (size_t)(xrow + 4 * aa) * CH + 32 * kk + 8 * fq);
#pragma unroll
        for (int h2 = 0; h2 < 4; ++h2) st4[kk][h2] = *((const f32x4*)(vstat + (size_t)(32 * kk + 8 * fq) * 2) + h2);
    }
#pragma unroll
    for (int tt = 0; tt < 8; ++tt) { u8v[tt] = *(const bf16x8*)(uz + (size_t)(16 * tt + fr) * D); c2v[tt] = c2t[16 * tt + fr]; bsv[tt] = bst[16 * tt + fr]; }
    float lg8[8], lb8[8];
    { const f32x4* gp = (const f32x4*)(a.in[3] + cw + 8 * fq); const f32x4* bp = (const f32x4*)(a.in[4] + cw + 8 * fq);
      const f32x4 g0 = gp[0], g1 = gp[1], b0 = bp[0], b1 = bp[1];
#pragma unroll
      for (int j = 0; j < 4; ++j) { lg8[j] = g0[j]; lg8[4 + j] = g1[j]; lb8[j] = b0[j]; lb8[4 + j] = b1[j]; } }
    bf16x8 xf[2][4];
#pragma unroll
    for (int kk = 0; kk < 4; ++kk) {
        float mu[8], rs[8];
#pragma unroll
        for (int h2 = 0; h2 < 4; ++h2) { const f32x4 v = st4[kk][h2];
            { const float m = v[0] * (1.0f / 2048.0f); float var = v[1] * (1.0f / 2048.0f) - m * m; var = var > 0.f ? var : 0.f; mu[2 * h2] = m; rs[2 * h2] = 1.0f / sqrtf(var + LN_EPS); }
            { const float m = v[2] * (1.0f / 2048.0f); float var = v[3] * (1.0f / 2048.0f) - m * m; var = var > 0.f ? var : 0.f; mu[2 * h2 + 1] = m; rs[2 * h2 + 1] = 1.0f / sqrtf(var + LN_EPS); } }
#pragma unroll
        for (int aa = 0; aa < 2; ++aa) {
            float v[8]; unpack8(xraw[aa][kk], v);
#pragma unroll
            for (int q = 0; q < 8; ++q) v[q] = (v[q] - mu[q]) * rs[q];
            xf[aa][kk] = pack8(v);
        }
    }
    asm volatile("" ::: "memory");
    {
        int yi = 0;
#pragma unroll
        for (int tt = 0; tt < 8; ++tt)
#pragma unroll
            for (int kk = 0; kk < 4; ++kk) if (kk <= (tt >> 1)) { yf[yi] = ldfrag(wsm + (size_t)(16 * tt + fr) * CH + 32 * kk + 8 * fq); ++yi; }
    }
    {
        int yi = 0;
#pragma unroll
        for (int tt = 0; tt < 8; ++tt) {
            f32x4 acc0 = (f32x4){0.f, 0.f, 0.f, 0.f}, acc1 = (f32x4){0.f, 0.f, 0.f, 0.f};
#pragma unroll
            for (int kk = 0; kk < 4; ++kk) if (kk <= (tt >> 1)) { acc0 = MFMA16(xf[0][kk], yf[yi], acc0); acc1 = MFMA16(xf[1][kk], yf[yi], acc1); ++yi; }
            const float c2 = c2v[tt], bs = bsv[tt];
            float u8[8]; unpack8(u8v[tt], u8);
#pragma unroll
            for (int r = 0; r < 4; ++r) { u8[r] *= lg8[r] * acc0[r] + lb8[r] * c2 + bs; u8[4 + r] *= lg8[4 + r] * acc1[r] + lb8[4 + r] * c2 + bs; }
            *(bf16x8*)(uz + (size_t)(16 * tt + fr) * D) = pack8(u8);
        }
    }
}

__device__ __forceinline__ void kv_task(const Args& a, int task, int lane) {
    unsigned char* ws = a.ws;
    const int w = task & 7, unit = task >> 3, n = unit & 31, h = (unit >> 5) & 7, b = unit >> 8;
    const int fr = lane & 15, fq = lane >> 4;
    const bf16_t* rvTb = (const bf16_t*)(ws + WS_RVT) + ((size_t)(b * NCH + n) * 2048 + h * 256 + 32 * w) * CH;
    const bf16_t* kTb = (const bf16_t*)(ws + WS_KT) + ((size_t)(b * NCH + n) * 1024 + h * 128) * CH;
    bf16_t* kvT = (bf16_t*)(ws + WS_KVT) + (size_t)((b * 8 + h) * NCH + n) * (256 * 128) + (size_t)(32 * w) * 128;
    const float lg = a.lg2[h];
    const int xrow = 8 * (fr >> 2) + (fr & 3);
    bf16x8 yraw[2][4], xf[4][2][4];
#pragma unroll
    for (int kk = 0; kk < 4; ++kk)
#pragma unroll
        for (int et = 0; et < 2; ++et) yraw[et][kk] = ldfrag(rvTb + (size_t)(16 * et + fr) * CH + 32 * kk + 8 * fq);
#pragma unroll
    for (int dp = 0; dp < 4; ++dp)
#pragma unroll
        for (int aa = 0; aa < 2; ++aa)
#pragma unroll
            for (int kk = 0; kk < 4; ++kk) xf[dp][aa][kk] = ldfrag(kTb + (size_t)(32 * dp + xrow + 4 * aa) * CH + 32 * kk + 8 * fq);
    bf16x8 yf[2][4];
#pragma unroll
    for (int kk = 0; kk < 4; ++kk) {
        float wd[8];
#pragma unroll
        for (int q = 0; q < 8; ++q) wd[q] = __builtin_amdgcn_exp2f(lg * (float)(127 - (32 * kk + 8 * fq + q)));
#pragma unroll
        for (int et = 0; et < 2; ++et) { float v[8]; unpack8(yraw[et][kk], v);
#pragma unroll
            for (int q = 0; q < 8; ++q) v[q] *= wd[q];
            yf[et][kk] = pack8(v); }
    }
#pragma unroll
    for (int dp = 0; dp < 4; ++dp) {
        f32x4 acc[2][2];
#pragma unroll
        for (int aa = 0; aa < 2; ++aa)
#pragma unroll
            for (int et = 0; et < 2; ++et) acc[aa][et] = (f32x4){0.f, 0.f, 0.f, 0.f};
#pragma unroll
        for (int kk = 0; kk < 4; ++kk)
#pragma unroll
            for (int aa = 0; aa < 2; ++aa) { acc[aa][0] = MFMA16(xf[dp][aa][kk], yf[0][kk], acc[aa][0]); acc[aa][1] = MFMA16(xf[dp][aa][kk], yf[1][kk], acc[aa][1]); }
#pragma unroll
        for (int et = 0; et < 2; ++et) {
            const float v[8] = {acc[0][et][0], acc[0][et][1], acc[0][et][2], acc[0][et][3], acc[1][et][0], acc[1][et][1], acc[1][et][2], acc[1][et][3]};
            *(bf16x8*)(kvT + (size_t)(16 * et + fr) * 128 + 32 * dp + 8 * fq) = pack8(v);
        }
    }
}

struct RetFrags { bf16x8 v[2][4], r[2][4]; };
__device__ __forceinline__ void ret_load(RetFrags& f, const bf16_t* rvTb, const bf16_t* RTb, int p, int xrow, int fq, int nsb) {
    const bf16_t* vr = rvTb + (size_t)(32 * p + xrow) * CH + 8 * fq;
    const bf16_t* rr = RTb + (size_t)(32 * p + xrow) * 128 + 8 * fq;
#pragma unroll
    for (int sb = 0; sb < 4; ++sb) if (sb < nsb) { f.v[0][sb] = ldfrag(vr + 32 * sb); f.v[1][sb] = ldfrag(vr + 4 * CH + 32 * sb); }
#pragma unroll
    for (int kk = 0; kk < 4; ++kk) { f.r[0][kk] = ldfrag(rr + 32 * kk); f.r[1][kk] = ldfrag(rr + 4 * 128 + 32 * kk); }
}
__device__ __forceinline__ void ret_compute(const RetFrags& f, const bf16x8 (&pf)[4], const bf16x8 (&qf)[4], int nsb, float cdec, LAS f32x4* ol, int p, float& sum, float& sq) {
    f32x4 ai0 = (f32x4){0.f, 0.f, 0.f, 0.f}, ai1 = ai0, ac0 = ai0, ac1 = ai0;
#pragma unroll
    for (int sb = 0; sb < 4; ++sb) if (sb < nsb) { ai0 = MFMA16(f.v[0][sb], pf[sb], ai0); ai1 = MFMA16(f.v[1][sb], pf[sb], ai1); }
#pragma unroll
    for (int kk = 0; kk < 4; ++kk) { ac0 = MFMA16(f.r[0][kk], qf[kk], ac0); ac1 = MFMA16(f.r[1][kk], qf[kk], ac1); }
    const f32x4 o0 = ai0 + ac0 * cdec, o1 = ai1 + ac1 * cdec;
    ol[(2 * p) * 64] = o0; ol[(2 * p + 1) * 64] = o1;
#pragma unroll
    for (int r = 0; r < 4; ++r) { sum += o0[r] + o1[r]; sq += o0[r] * o0[r] + o1[r] * o1[r]; }
}
__device__ __forceinline__ void ret_task(const Args& a, int task, int lane, int wave, LAS unsigned char* lds) {
    unsigned char* ws = a.ws;
    const int w = task & 7, unit = task >> 3, n = unit & 31, h = (unit >> 5) & 7, b = unit >> 8;
    const int fr = lane & 15, fq = lane >> 4;
    const int t0 = b * SEQ + n * CH, tl = 16 * w + fr;
    const bf16_t* qg = (const bf16_t*)(ws + WS_Q) + (size_t)(t0 + tl) * 1024 + h * 128;
    const bf16_t* kg = (const bf16_t*)(ws + WS_K) + (size_t)t0 * 1024 + h * 128;
    const bf16_t* rvTb = (const bf16_t*)(ws + WS_RVT) + ((size_t)(b * NCH + n) * 2048 + h * 256) * CH;
    const bf16_t* RTb = (const bf16_t*)(ws + WS_RT) + (size_t)((b * 8 + h) * NCH + n) * (256 * 128);
    bf16_t* rzp = (bf16_t*)(ws + WS_RZ) + (size_t)(t0 + tl) * D + h * 256 + 8 * fq;
    const float lg = a.lg2[h];
    const int xrow = 8 * (fr >> 2) + (fr & 3);
    const int nsb = (w >> 1) + 1;
    bf16x8 qf[4], kf[4][2][4], zv[8];
#pragma unroll
    for (int kk = 0; kk < 4; ++kk) qf[kk] = ldfrag(qg + 32 * kk + 8 * fq);
#pragma unroll
    for (int sb = 0; sb < 4; ++sb) if (sb < nsb) {
#pragma unroll
        for (int kk = 0; kk < 4; ++kk) { kf[sb][0][kk] = ldfrag(kg + (size_t)(32 * sb + xrow) * 1024 + 32 * kk + 8 * fq); kf[sb][1][kk] = ldfrag(kg + (size_t)(32 * sb + xrow + 4) * 1024 + 32 * kk + 8 * fq); }
    }
    RetFrags fa, fb;
    bf16x8 pf[4];
#pragma unroll
    for (int sb = 0; sb < 4; ++sb) {
        pf[sb] = (bf16x8){0, 0, 0, 0, 0, 0, 0, 0};
        if (sb < nsb) {
            f32x4 s0 = (f32x4){0.f, 0.f, 0.f, 0.f}, s1 = (f32x4){0.f, 0.f, 0.f, 0.f};
#pragma unroll
            for (int kk = 0; kk < 4; ++kk) { s0 = MFMA16(kf[sb][0][kk], qf[kk], s0); s1 = MFMA16(kf[sb][1][kk], qf[kk], s1); }
            float p[8];
#pragma unroll
            for (int r = 0; r < 4; ++r) {
                const int sa = 32 * sb + 8 * fq + r, sbb = sa + 4;
                p[r] = (sa <= tl) ? s0[r] * __builtin_amdgcn_exp2f(lg * (float)(tl - sa)) : 0.f;
                p[4 + r] = (sbb <= tl) ? s1[r] * __builtin_amdgcn_exp2f(lg * (float)(tl - sbb)) : 0.f;
            }
            pf[sb] = pack8(p);
        }
    }
    asm volatile("" ::: "memory");
    ret_load(fa, rvTb, RTb, 0, xrow, fq, nsb);
    const float cdec = __builtin_amdgcn_exp2f(lg * (float)(tl + 1));
    LAS f32x4* ol = (LAS f32x4*)(lds + wave * 16384) + lane;
    float sum = 0.f, sq = 0.f;
#pragma unroll 1
    for (int p = 0; p < 8; p += 2) {
        ret_load(fb, rvTb, RTb, p + 1, xrow, fq, nsb);
        ret_compute(fa, pf, qf, nsb, cdec, ol, p, sum, sq);
        if (p + 2 < 8) ret_load(fa, rvTb, RTb, p + 2, xrow, fq, nsb);
        ret_compute(fb, pf, qf, nsb, cdec, ol, p + 1, sum, sq);
    }
    asm volatile("" ::: "memory");
#pragma unroll
    for (int p = 0; p < 8; ++p) zv[p] = *(const bf16x8*)(rzp + 32 * p);
    sum += __shfl_xor(sum, 16); sum += __shfl_xor(sum, 32); sq += __shfl_xor(sq, 16); sq += __shfl_xor(sq, 32);
    const float mean = sum * (1.0f / 256.0f); float var = sq * (1.0f / 256.0f) - mean * mean; var = var > 0.f ? var : 0.f;
    const float rstd = 1.0f / sqrtf(var + LN_EPS);
#pragma unroll
    for (int p = 0; p < 8; ++p) {
        const f32x4 o0 = ol[(2 * p) * 64], o1 = ol[(2 * p + 1) * 64];
        float z[8]; unpack8(zv[p], z);
#pragma unroll
        for (int r = 0; r < 4; ++r) { z[r] *= (o0[r] - mean) * rstd; z[4 + r] *= (o1[r] - mean) * rstd; }
        *(bf16x8*)(rzp + 32 * p) = pack8(z);
    }
}


__device__ __forceinline__ int swz_pair(int row, int ch) { return row * 256 + ((ch ^ ((((row >> 3) & 3) << 2) | (row & 3))) << 4); }
__device__ __forceinline__ int swz_lin(int row, int ch) { return row * 256 + ((ch ^ (row & 15)) << 4); }
__device__ __forceinline__ bf16x8 ldsfrag(LAS unsigned char* p) { return *(const LAS bf16x8*)p; }

__device__ __forceinline__ void gate_task_lds(const Args& a, int task, int lane, LAS unsigned char* lds) {
    unsigned char* ws = a.ws;
    const int w = task & 7, unit = task >> 3, g = unit & 7, n = (unit >> 3) & 31, b = unit >> 8;
    const int fr = lane & 15, fq = lane >> 4;
    const int t0 = b * SEQ + n * CH, cw = g * 256 + w * 32;
    const bf16_t* vTb = (const bf16_t*)(ws + WS_VT) + ((size_t)(b * NCH + n) * 2048 + cw) * CH;
    const float* vstat = (const float*)(ws + WS_VSTAT) + (size_t)t0 * 2;
    const float* c2t = (const float*)(ws + WS_C2) + g * CH; const float* bst = a.in[6] + g * CH;
    bf16_t* uz = (bf16_t*)(ws + WS_UZ) + (size_t)t0 * D + cw + 8 * fq;
    const int xrow = 8 * (fr >> 2) + (fr & 3);
    bf16x8 xraw[2][4]; f32x4 st4[4][4]; bf16x8 u8v[8]; float c2v[8], bsv[8];
#pragma unroll
    for (int kk = 0; kk < 4; ++kk) {
#pragma unroll
        for (int aa = 0; aa < 2; ++aa) xraw[aa][kk] = ldfrag(vTb + (size_t)(xrow + 4 * aa) * CH + 32 * kk + 8 * fq);
#pragma unroll
        for (int h2 = 0; h2 < 4; ++h2) st4[kk][h2] = *((const f32x4*)(vstat + (size_t)(32 * kk + 8 * fq) * 2) + h2);
    }
#pragma unroll
    for (int tt = 0; tt < 8; ++tt) { u8v[tt] = *(const bf16x8*)(uz + (size_t)(16 * tt + fr) * D); c2v[tt] = c2t[16 * tt + fr]; bsv[tt] = bst[16 * tt + fr]; }
    float lg8[8], lb8[8];
    { const f32x4* gp = (const f32x4*)(a.in[3] + cw + 8 * fq); const f32x4* bp = (const f32x4*)(a.in[4] + cw + 8 * fq);
      const f32x4 g0 = gp[0], g1 = gp[1], b0 = bp[0], b1 = bp[1];
#pragma unroll
      for (int j = 0; j < 4; ++j) { lg8[j] = g0[j]; lg8[4 + j] = g1[j]; lb8[j] = b0[j]; lb8[4 + j] = b1[j]; } }
    bf16x8 xf[2][4];
#pragma unroll
    for (int kk = 0; kk < 4; ++kk) {
        float mu[8], rs[8];
#pragma unroll
        for (int h2 = 0; h2 < 4; ++h2) { const f32x4 v = st4[kk][h2];
            { const float m = v[0] * (1.0f / 2048.0f); float var = v[1] * (1.0f / 2048.0f) - m * m; var = var > 0.f ? var : 0.f; mu[2 * h2] = m; rs[2 * h2] = 1.0f / sqrtf(var + LN_EPS); }
            { const float m = v[2] * (1.0f / 2048.0f); float var = v[3] * (1.0f / 2048.0f) - m * m; var = var > 0.f ? var : 0.f; mu[2 * h2 + 1] = m; rs[2 * h2 + 1] = 1.0f / sqrtf(var + LN_EPS); } }
#pragma unroll
        for (int aa = 0; aa < 2; ++aa) {
            float v[8]; unpack8(xraw[aa][kk], v);
#pragma unroll
            for (int q = 0; q < 8; ++q) v[q] = (v[q] - mu[q]) * rs[q];
            xf[aa][kk] = pack8(v);
        }
    }
    LAS unsigned char* yb = lds + fr * 256;
    int cy[4];
#pragma unroll
    for (int kk = 0; kk < 4; ++kk) cy[kk] = ((4 * kk + fq) ^ fr) << 4;
#pragma unroll
    for (int tt = 0; tt < 8; ++tt) {
        asm volatile("" ::: "memory");
        f32x4 acc0 = (f32x4){0.f, 0.f, 0.f, 0.f}, acc1 = (f32x4){0.f, 0.f, 0.f, 0.f};
#pragma unroll
        for (int kk = 0; kk < 4; ++kk) if (kk <= (tt >> 1)) { const bf16x8 yf = ldsfrag(yb + tt * 4096 + cy[kk]); acc0 = MFMA16(xf[0][kk], yf, acc0); acc1 = MFMA16(xf[1][kk], yf, acc1); }
        const float c2 = c2v[tt], bs = bsv[tt];
        float u8[8]; unpack8(u8v[tt], u8);
#pragma unroll
        for (int r = 0; r < 4; ++r) { u8[r] *= lg8[r] * acc0[r] + lb8[r] * c2 + bs; u8[4 + r] *= lg8[4 + r] * acc1[r] + lb8[4 + r] * c2 + bs; }
        *(bf16x8*)(uz + (size_t)(16 * tt + fr) * D) = pack8(u8);
    }
}

__device__ __forceinline__ void kv_unit_lds(const Frame& F, const Args& a, int unit, int koff) {
    unsigned char* ws = a.ws;
    const int w = F.wave, lane = F.lane, n = unit & 31, h = (unit >> 5) & 7, b = unit >> 8;
    const int fr = lane & 15, fq = lane >> 4;
    const bf16_t* rvTb = (const bf16_t*)(ws + WS_RVT) + ((size_t)(b * NCH + n) * 2048 + h * 256 + 32 * w) * CH;
    const bf16_t* kTb = (const bf16_t*)(ws + WS_KT) + ((size_t)(b * NCH + n) * 1024 + h * 128) * CH;
    bf16_t* kvT = (bf16_t*)(ws + WS_KVT) + (size_t)((b * 8 + h) * NCH + n) * (256 * 128) + (size_t)(32 * w) * 128;
    const float lg = a.lg2[h];
    u32x4 kc[4];
#pragma unroll
    for (int j = 0; j < 4; ++j) { const int idx = F.tid + 512 * j; kc[j] = *(const u32x4*)(kTb + (size_t)(idx >> 4) * CH + (idx & 15) * 8); }
    bf16x8 yraw[2][4];
#pragma unroll
    for (int kk = 0; kk < 4; ++kk)
#pragma unroll
        for (int et = 0; et < 2; ++et) yraw[et][kk] = ldfrag(rvTb + (size_t)(16 * et + fr) * CH + 32 * kk + 8 * fq);
#pragma unroll
    for (int j = 0; j < 4; ++j) { const int idx = F.tid + 512 * j; *(LAS u32x4*)(F.lds + koff + swz_pair(idx >> 4, idx & 15)) = kc[j]; }
    bf16x8 yf[2][4];
#pragma unroll
    for (int kk = 0; kk < 4; ++kk) {
        float wd[8];
#pragma unroll
        for (int q = 0; q < 8; ++q) wd[q] = __builtin_amdgcn_exp2f(lg * (float)(127 - (32 * kk + 8 * fq + q)));
#pragma unroll
        for (int et = 0; et < 2; ++et) { float v[8]; unpack8(yraw[et][kk], v);
#pragma unroll
            for (int q = 0; q < 8; ++q) v[q] *= wd[q];
            yf[et][kk] = pack8(v); }
    }
    __syncthreads();
    const int xrow = 8 * (fr >> 2) + (fr & 3);
    LAS unsigned char* xb = F.lds + koff + xrow * 256;
    int cx[4];
#pragma unroll
    for (int kk = 0; kk < 4; ++kk) cx[kk] = ((4 * kk + fq) ^ fr) << 4;
#pragma unroll
    for (int dp = 0; dp < 4; ++dp) {
        f32x4 acc[2][2];
#pragma unroll
        for (int aa = 0; aa < 2; ++aa)
#pragma unroll
            for (int et = 0; et < 2; ++et) acc[aa][et] = (f32x4){0.f, 0.f, 0.f, 0.f};
#pragma unroll
        for (int kk = 0; kk < 4; ++kk)
#pragma unroll
            for (int aa = 0; aa < 2; ++aa) { const bf16x8 xf = ldsfrag(xb + (32 * dp + 4 * aa) * 256 + cx[kk]); acc[aa][0] = MFMA16(xf, yf[0][kk], acc[aa][0]); acc[aa][1] = MFMA16(xf, yf[1][kk], acc[aa][1]); }
#pragma unroll
        for (int et = 0; et < 2; ++et) {
            const float v[8] = {acc[0][et][0], acc[0][et][1], acc[0][et][2], acc[0][et][3], acc[1][et][0], acc[1][et][1], acc[1][et][2], acc[1][et][3]};
            *(bf16x8*)(kvT + (size_t)(16 * et + fr) * 128 + 32 * dp + 8 * fq) = pack8(v);
        }
    }
}

__device__ __forceinline__ void ret_unit_lds(const Frame& F, const Args& a, int unit) {
    unsigned char* ws = a.ws;
    const int w = F.wave, lane = F.lane, n = unit & 31, h = (unit >> 5) & 7, b = unit >> 8;
    const int fr = lane & 15, fq = lane >> 4;
    const int t0 = b * SEQ + n * CH, tl = 16 * w + fr;
    const bf16_t* qg = (const bf16_t*)(ws + WS_Q) + (size_t)(t0 + tl) * 1024 + h * 128;
    const bf16_t* kg = (const bf16_t*)(ws + WS_K) + (size_t)t0 * 1024 + h * 128;
    const bf16_t* rvTb = (const bf16_t*)(ws + WS_RVT) + ((size_t)(b * NCH + n) * 2048 + h * 256) * CH;
    const bf16_t* RTb = (const bf16_t*)(ws + WS_RT) + (size_t)((b * 8 + h) * NCH + n) * (256 * 128);
    bf16_t* rzp = (bf16_t*)(ws + WS_RZ) + (size_t)(t0 + tl) * D + h * 256 + 8 * fq;
    const float lg = a.lg2[h];
    constexpr int KOFF = 0, VOFF = 32768, ROFF = 98304;
    LAS unsigned char* L = F.lds;
    { u32x4 kc[4], vc[8];
#pragma unroll
      for (int j = 0; j < 4; ++j) { const int idx = F.tid + 512 * j; kc[j] = *(const u32x4*)(kg + (size_t)(idx >> 4) * 1024 + (idx & 15) * 8); }
#pragma unroll
      for (int j = 0; j < 8; ++j) { const int idx = F.tid + 512 * j; vc[j] = *(const u32x4*)(rvTb + (size_t)idx * 8); }
#pragma unroll
      for (int j = 0; j < 4; ++j) { const int idx = F.tid + 512 * j; *(LAS u32x4*)(L + KOFF + swz_pair(idx >> 4, idx & 15)) = kc[j]; }
#pragma unroll
      for (int j = 0; j < 8; ++j) { const int idx = F.tid + 512 * j; *(LAS u32x4*)(L + VOFF + swz_pair(idx >> 4, idx & 15)) = vc[j]; } }
    u32x4 rc[4];
    { u32x4 r0[4];
#pragma unroll
      for (int j = 0; j < 4; ++j) { const int idx = F.tid + 512 * j; r0[j] = *(const u32x4*)(RTb + (size_t)idx * 8); }
#pragma unroll
      for (int j = 0; j < 4; ++j) { const int idx = F.tid + 512 * (j + 4); rc[j] = *(const u32x4*)(RTb + (size_t)idx * 8); }
#pragma unroll
      for (int j = 0; j < 4; ++j) { const int idx = F.tid + 512 * j; *(LAS u32x4*)(L + ROFF + swz_pair(idx >> 4, idx & 15)) = r0[j]; } }
    bf16x8 qf[4];
#pragma unroll
    for (int kk = 0; kk < 4; ++kk) qf[kk] = ldfrag(qg + 32 * kk + 8 * fq);
    __syncthreads();
    const int xrow = 8 * (fr >> 2) + (fr & 3);
    const int nsb = (w >> 1) + 1;
    int cx[4];
#pragma unroll
    for (int kk = 0; kk < 4; ++kk) cx[kk] = xrow * 256 + (((4 * kk + fq) ^ fr) << 4);
    bf16x8 pf[4];
#pragma unroll
    for (int sb = 0; sb < 4; ++sb) {
        pf[sb] = (bf16x8){0, 0, 0, 0, 0, 0, 0, 0};
        if (sb < nsb) {
            f32x4 s0 = (f32x4){0.f, 0.f, 0.f, 0.f}, s1 = (f32x4){0.f, 0.f, 0.f, 0.f};
#pragma unroll
            for (int kk = 0; kk < 4; ++kk) { s0 = MFMA16(ldsfrag(L + KOFF + (32 * sb) * 256 + cx[kk]), qf[kk], s0); s1 = MFMA16(ldsfrag(L + KOFF + (32 * sb + 4) * 256 + cx[kk]), qf[kk], s1); }
            float p[8];
#pragma unroll
            for (int r = 0; r < 4; ++r) {
                const int sa = 32 * sb + 8 * fq + r, sbb = sa + 4;
                p[r] = (sa <= tl) ? s0[r] * __builtin_amdgcn_exp2f(lg * (float)(tl - sa)) : 0.f;
                p[4 + r] = (sbb <= tl) ? s1[r] * __builtin_amdgcn_exp2f(lg * (float)(tl - sbb)) : 0.f;
            }
            pf[sb] = pack8(p);
        }
    }
    __syncthreads();
#pragma unroll
    for (int j = 0; j < 4; ++j) { const int idx = F.tid + 512 * j; *(LAS u32x4*)(L + KOFF + swz_pair(idx >> 4, idx & 15)) = rc[j]; }
    f32x4 o[8][2];
#pragma unroll
    for (int p = 0; p < 8; ++p) {
        f32x4 ai0 = (f32x4){0.f, 0.f, 0.f, 0.f}, ai1 = ai0;
#pragma unroll
        for (int sb = 0; sb < 4; ++sb) if (sb < nsb) { ai0 = MFMA16(ldsfrag(L + VOFF + (32 * p) * 256 + cx[sb]), pf[sb], ai0); ai1 = MFMA16(ldsfrag(L + VOFF + (32 * p + 4) * 256 + cx[sb]), pf[sb], ai1); }
        o[p][0] = ai0; o[p][1] = ai1;
    }
    bf16x8 zv[8];
#pragma unroll
    for (int p = 0; p < 8; ++p) zv[p] = *(const bf16x8*)(rzp + 32 * p);
    __syncthreads();
    const float cdec = __builtin_amdgcn_exp2f(lg * (float)(tl + 1));
    float sum = 0.f, sq = 0.f;
#pragma unroll
    for (int p = 0; p < 8; ++p) {
        f32x4 ac0 = (f32x4){0.f, 0.f, 0.f, 0.f}, ac1 = ac0;
        const int rb = (p < 4 ? ROFF : KOFF) + (32 * (p & 3)) * 256;
#pragma unroll
        for (int kk = 0; kk < 4; ++kk) { ac0 = MFMA16(ldsfrag(L + rb + cx[kk]), qf[kk], ac0); ac1 = MFMA16(ldsfrag(L + rb + 4 * 256 + cx[kk]), qf[kk], ac1); }
        o[p][0] += ac0 * cdec; o[p][1] += ac1 * cdec;
#pragma unroll
        for (int r = 0; r < 4; ++r) { sum += o[p][0][r] + o[p][1][r]; sq += o[p][0][r] * o[p][0][r] + o[p][1][r] * o[p][1][r]; }
    }
    sum += __shfl_xor(sum, 16); sum += __shfl_xor(sum, 32); sq += __shfl_xor(sq, 16); sq += __shfl_xor(sq, 32);
    const float mean = sum * (1.0f / 256.0f); float var = sq * (1.0f / 256.0f) - mean * mean; var = var > 0.f ? var : 0.f;
    const float rstd = 1.0f / sqrtf(var + LN_EPS);
#pragma unroll
    for (int p = 0; p < 8; ++p) {
        float z[8]; unpack8(zv[p], z);
#pragma unroll
        for (int r = 0; r < 4; ++r) { z[r] *= (o[p][0][r] - mean) * rstd; z[4 + r] *= (o[p][1][r] - mean) * rstd; }
        *(bf16x8*)(rzp + 32 * p) = pack8(z);
    }
    __syncthreads();
}

__device__ __forceinline__ void ln_phase(const Frame& F, const Args& a) {
    const int gw = F.vcu * 8 + F.wave, NGW = F.G * 8;
    const float* g = a.in[10]; const float* bb = a.in[11];
    for (int m = gw; m < M; m += NGW) {
        f32x4* row = (f32x4*)(a.out + (size_t)m * D) + F.lane;
        f32x4 v[8]; float s = 0.f;
#pragma unroll
        for (int j = 0; j < 8; ++j) { v[j] = row[64 * j]; s += (v[j][0] + v[j][1]) + (v[j][2] + v[j][3]); }
        const float mean = wave_sum(s) * (1.0f / D); float s2 = 0.f;
#pragma unroll
        for (int j = 0; j < 8; ++j) { v[j] = v[j] - mean; s2 += (v[j][0] * v[j][0] + v[j][1] * v[j][1]) + (v[j][2] * v[j][2] + v[j][3] * v[j][3]); }
        const float rstd = 1.0f / sqrtf(wave_sum(s2) * (1.0f / D) + LN_EPS);
#pragma unroll
        for (int j = 0; j < 8; ++j) { const f32x4 gg = *((const f32x4*)g + F.lane + 64 * j), bv = *((const f32x4*)bb + F.lane + 64 * j); row[64 * j] = v[j] * rstd * gg + bv; }
    }
}

__global__ void __launch_bounds__(512, 2) mk_fwd(Args args) {
    extern __shared__ __attribute__((aligned(16))) unsigned char lds_raw[];
    Frame F;
    F.lds = (LAS unsigned char*)lds_raw;
    F.tid = threadIdx.x; F.lane = F.tid & 63; F.wave = __builtin_amdgcn_readfirstlane(F.tid >> 6);
    F.G = gridDim.x; { const int bx = blockIdx.x; F.vcu = (F.G % 8 == 0) ? (bx % 8) * (F.G / 8) + bx / 8 : bx; }
    unsigned char* ws = args.ws;
    const int lo = args.ph_lo, hi = args.ph_hi;
#define IN(k) (lo <= (k) && (k) < hi)
#define BOTH(k) (IN(k) && IN((k) + 1))
#if MK_XCD_BARRIER
    volatile LAS unsigned* MISC = (volatile LAS unsigned*)(F.lds + 131072 + 320);
    if (F.tid < 32) MISC[F.tid] = 0u;
    __syncthreads();
    XcdBarrier xbar; xbar.bar = (unsigned*)(ws + WS_CTL) + CW_BAR; xbar.x = 0; xbar.st = nullptr;
    if (hi - lo > 1) xbar = xcd_barrier_post((unsigned*)(ws + WS_CTL) + CW_BAR, MISC + 8);
#define GRID_BAR() do { xcd_barrier(xbar); } while (0)
#else
#define GRID_BAR() do { cg::this_grid().sync(); } while (0)
#endif

    if (IN(0)) { p0_prologue(F, args); if (BOTH(0)) GRID_BAR(); }
    if (IN(1)) {
        OrderP1 S{F.G, (int)blockIdx.x, (const char*)(ws + WS_XB), (const char*)(ws + WS_WIN)};
        EpiP1 E{ws, (bf16_t*)args.out, args.in[2]};
        pg8::gemm_phase<EpiP1, OrderP1>(F.lds, S, E);
        if (BOTH(1)) GRID_BAR();
    }
    if (IN(2)) {
#if MIX_LDS_GATE
        {
            const bf16_t* wsm = (const bf16_t*)(ws + WS_WSM) + (size_t)(F.vcu & 7) * CH * CH;
            u32x4 wc4[4];
#pragma unroll
            for (int j = 0; j < 4; ++j) { const int idx = F.tid + 512 * j; wc4[j] = *(const u32x4*)(wsm + (size_t)idx * 8); }
#pragma unroll
            for (int j = 0; j < 4; ++j) { const int idx = F.tid + 512 * j; *(LAS u32x4*)(F.lds + swz_lin(idx >> 4, idx & 15)) = wc4[j]; }
            __syncthreads();
        }
        for (int task = F.vcu * 8 + F.wave; task < 8192; task += F.G * 8) gate_task_lds(args, task, F.lane, F.lds);
#elif MIX_GATE
        for (int task = F.vcu * 8 + F.wave; task < 8192; task += F.G * 8) gate_task(args, task, F.lane);
#else
        for (int u = F.vcu; u < 1024; u += F.G) naive_gate_unit(F, args, u);
#endif
#if MIX_LDS_KV
        { int par = 0; for (int u = F.vcu; u < 1024; u += F.G) { kv_unit_lds(F, args, u, 32768 + par * 32768); par ^= 1; } }
#elif MIX_KV
        for (int task = F.vcu * 8 + F.wave; task < 8192; task += F.G * 8) kv_task(args, task, F.lane);
#else
        for (int u = F.vcu; u < 1024; u += F.G) naive_kv_unit(F, args, u);
#endif
        __syncthreads();
        if (BOTH(2)) GRID_BAR();
    }
    if (IN(3)) { scan_phase(F, args); if (BOTH(3)) GRID_BAR(); }
    if (IN(4)) {
#if MIX_LDS_RET
        for (int u = F.vcu; u < 1024; u += F.G) ret_unit_lds(F, args, u);
#elif MIX_RET
        for (int task = F.vcu * 8 + F.wave; task < 8192; task += F.G * 8) ret_task(args, task, F.lane, F.wave, F.lds);
#else
        for (int u = F.vcu; u < 1024; u += F.G) naive_ret_unit(F, args, u);
#endif
        __syncthreads();
        if (BOTH(4)) GRID_BAR();
    }
    if (IN(5)) {
        OrderP3 S{F.G, (int)blockIdx.x, (const char*)(ws + WS_UZ), (const char*)(ws + WS_RZ), (const char*)(ws + WS_WOA), (const char*)(ws + WS_WOB)};
        EpiP3 E{(const bf16_t*)args.out, (const bf16_t*)args.out + (size_t)M * D, (bf16_t*)(ws + WS_MB)};
        pg8::gemm_phase<EpiP3, OrderP3>(F.lds, S, E);
        if (BOTH(5)) GRID_BAR();
    }
    if (IN(6)) {
        OrderP4 S{F.G, (int)blockIdx.x, (const char*)(ws + WS_MB), (const char*)(ws + WS_WOUT)};
        EpiP4 E{args.in[0], args.out};
        pg8::gemm_phase<EpiP4, OrderP4>(F.lds, S, E);
        if (BOTH(6)) GRID_BAR();
    }
    if (IN(7)) { ln_phase(F, args); }
#undef IN
#undef BOTH
}

extern "C" void kernel_launch(void* const* d_in, const int* in_sizes, int n_in, void* d_out, int out_size, void* d_ws, size_t ws_size, hipStream_t stream) {
    static int grid = 0;
    if (grid == 0) {
        if (n_in != 12 || out_size != M * D || ws_size < WS_END) { fprintf(stderr, "kernel_launch: unexpected shapes (n_in %d, out %d, ws %zu)\n", n_in, out_size, ws_size); grid = -1; return; }
        int dev = 0, cus = 0, per_cu = 0;
        if (hipGetDevice(&dev) != hipSuccess || hipDeviceGetAttribute(&cus, hipDeviceAttributeMultiprocessorCount, dev) != hipSuccess) { grid = -1; return; }
        if (hipFuncSetAttribute((const void*)mk_fwd, hipFuncAttributeMaxDynamicSharedMemorySize, LDS_BYTES) != hipSuccess) { fprintf(stderr, "kernel_launch: hipFuncSetAttribute failed\n"); grid = -1; return; }
        if (hipOccupancyMaxActiveBlocksPerMultiprocessor(&per_cu, (const void*)mk_fwd, 512, LDS_BYTES) != hipSuccess || per_cu < 1) { fprintf(stderr, "kernel_launch: occupancy query says %d blocks per CU\n", per_cu); grid = -1; return; }
        (void)hipGetLastError();
        grid = cus;
    }
    if (grid < 0) return;
    Args a{};
    for (int i = 0; i < 12; ++i) a.in[i] = (const float*)d_in[i];
    a.out = (float*)d_out; a.ws = (unsigned char*)d_ws;
    for (int j = 0; j < 64; ++j) a.freq[j] = (float)std::pow(10000.0, -(double)(2 * j) / 128.0);
    for (int h = 0; h < 8; ++h) a.lg2[h] = (float)(std::log1p(-std::exp2(-5.0 - (double)h)) / std::log(2.0));
#if MK_N_LAUNCHES == 1 && MK_XCD_BARRIER
    a.ph_lo = 0; a.ph_hi = 8;
    if (hipMemsetAsync((char*)d_ws + WS_CTL, 0, CTL_ZERO_BYTES, stream) != hipSuccess) { fprintf(stderr, "kernel_launch: memset failed\n"); return; }
    hipLaunchKernelGGL(mk_fwd, dim3(grid), dim3(512), LDS_BYTES, stream, a);
#elif MK_N_LAUNCHES == 1
    a.ph_lo = 0; a.ph_hi = 8;
    void* kargs[] = {&a};
    hipError_t e = hipLaunchCooperativeKernel((const void*)mk_fwd, dim3(grid), dim3(512), kargs, LDS_BYTES, stream);
    if (e != hipSuccess) fprintf(stderr, "kernel_launch: cooperative launch failed: %s (grid %d)\n", hipGetErrorString(e), grid);
#else
    for (int p = 0; p < 8; ++p) { a.ph_lo = p; a.ph_hi = p + 1; hipLaunchKernelGGL(mk_fwd, dim3(grid), dim3(512), LDS_BYTES, stream, a); }
#endif
}
```
